# Optimizing an MI355X kernel written in HIP

```python
import jax, jax.numpy as jnp
from jax import lax
import numpy as np

D_MODEL = 2048
BATCH = 4
SEQ = 2048
DEPTH = 1
DEC_BATCH = 128
DEC_SEQ = 4
PAST_LEN = 16384
PAGE_SIZE = 128

D_A = D_MODEL // 2
D_B = D_MODEL - D_A
DK = 128
H_A = D_A // DK
DV = D_A // H_A
CONV_W = 3
N_META = 16
CHUNK = 64
D_FF = -(-8 * D_MODEL // (3 * 256)) * 256
ALPHA = (2 * DEPTH) ** 0.25
BETA = (8 * DEPTH) ** -0.25
LN_EPS = 1e-5
RMS_EPS = 1e-6
N_IN = 2 * H_A * DK + 2 * H_A * DV + 3 * D_B

kernel_name = "hgrn2_shortconv_hybrid_step"


def _layernorm(x, g, b):
    xf = x.astype(jnp.float32)
    mu = jnp.mean(xf, axis=-1, keepdims=True)
    var = jnp.mean(jnp.square(xf - mu), axis=-1, keepdims=True)
    return ((xf - mu) * lax.rsqrt(var + LN_EPS) * g.astype(jnp.float32) + b.astype(jnp.float32)).astype(x.dtype)


def _gla_chunked(q, k, v, logf, S0):
    B, L, H, _ = q.shape
    c = min(CHUNK, L)
    n = -(-L // c)
    pad = n * c - L

    def prep(t):
        t = jnp.pad(t, ((0, 0), (0, pad), (0, 0), (0, 0)))
        return t.reshape(B, n, c, H, t.shape[-1]).transpose(1, 0, 3, 2, 4)

    qs, ks, vs, gs = prep(q), prep(k), prep(v), prep(logf)
    causal = jnp.tril(jnp.ones((c, c), dtype=bool))
    mid = c // 2

    def step(S, inp):
        qc, kc, vc, gc = inp
        b = jnp.cumsum(gc, axis=2)
        b_mid = b[:, :, mid:mid + 1]
        b_last = b[:, :, -1:]
        a = jnp.einsum('bhtk,bhsk->bhts', qc * jnp.exp(b - b_mid), kc * jnp.exp(b_mid - b))
        a = jnp.where(causal, a, 0.0)
        o = (jnp.einsum('bhts,bhsv->bhtv', a, vc)
             + jnp.einsum('bhtk,bhkv->bhtv', qc * jnp.exp(b), S))
        S = (jnp.exp(b_last[:, :, 0, :, None]) * S
             + jnp.einsum('bhsk,bhsv->bhkv', kc * jnp.exp(b_last - b), vc))
        return S, o

    S, o = lax.scan(step, S0.astype(jnp.float32), (qs, ks, vs, gs))
    o = o.transpose(1, 0, 3, 2, 4).reshape(B, n * c, H, DV)[:, :L]
    return o, S


def _layer(x, S0, buf, n_lead, lb, w_in, b_f, gnorm_g, conv_w, w_o,
           ln1_g, ln1_b, w_gate, w_up, w_down, ln2_g, ln2_b):
    f32 = jnp.float32
    Bsz, L, _ = x.shape
    proj = x @ w_in
    cuts = np.cumsum([H_A * DK, H_A * DK, H_A * DV, H_A * DV, D_B, D_B]).tolist()
    q, zf, v, g, gate_b, gate_c, xin = jnp.split(proj, cuts, axis=-1)

    zf = zf.astype(f32) + b_f.astype(f32)
    logf = jnp.logaddexp(jnp.log(lb), jnp.log1p(-lb) + jax.nn.log_sigmoid(zf))
    k = (1.0 - lb) * jax.nn.sigmoid(-zf)
    heads = lambda t: t.astype(f32).reshape(Bsz, L, H_A, -1)
    qh, kh, vh, gh = heads(jax.nn.silu(q.astype(f32))), heads(k), heads(v), heads(logf)
    if n_lead:
        o1, S1 = _gla_chunked(qh[:, :n_lead], kh[:, :n_lead], vh[:, :n_lead], gh[:, :n_lead], S0)
        o2, S = _gla_chunked(qh[:, n_lead:], kh[:, n_lead:], vh[:, n_lead:], gh[:, n_lead:], S1)
        o = jnp.concatenate([o1, o2], axis=1)
    else:
        o, S = _gla_chunked(qh, kh, vh, gh, S0)
    o = o * lax.rsqrt(jnp.mean(jnp.square(o), axis=-1, keepdims=True) + RMS_EPS)
    o_a = (o.reshape(Bsz, L, H_A * DV) * gnorm_g.astype(f32) * jax.nn.silu(g.astype(f32))).astype(x.dtype)

    u = gate_c * xin
    full = jnp.concatenate([buf.astype(u.dtype), u], axis=1)
    conv = sum(conv_w[j] * full[:, j:j + L] for j in range(CONV_W))
    y_b = gate_b * conv
    new_buf = full[:, -(CONV_W - 1):]

    mix = jnp.concatenate([o_a, y_b], axis=-1) @ w_o
    h = _layernorm(ALPHA * x + mix, ln1_g, ln1_b)
    ff = (jax.nn.silu(h @ w_gate) * (h @ w_up)) @ w_down
    out = _layernorm(ALPHA * h + ff, ln2_g, ln2_b)
    return out, S, new_buf


def setup_inputs(seed: int = 0) -> dict:
    key = jax.random.key(seed)
    ks = jax.random.split(key, 24)
    nrm = lambda i, shape: jax.random.normal(ks[i], shape, jnp.float32)
    col_scale = jnp.concatenate([
        jnp.ones((2 * H_A * DK,)),
        jnp.full((H_A * DV,), BETA),
        jnp.ones((H_A * DV + 2 * D_B,)),
        jnp.full((D_B,), BETA),
    ]).astype(jnp.float32)
    return {
        "x_prompt": nrm(0, (BATCH, SEQ, D_MODEL)),
        "x_sample": nrm(1, (DEC_BATCH, DEC_SEQ, D_MODEL)),
        "state_hgrn": 0.5 * nrm(2, (DEPTH, DEC_BATCH, H_A, DK, DV)),
        "state_conv": nrm(3, (DEPTH, DEC_BATCH, CONV_W - 1, D_B)),
        "meta_tokens": nrm(4, (N_META, D_MODEL)),
        "ln0_g": 1.0 + 0.02 * nrm(5, (D_MODEL,)),
        "ln0_b": 0.02 * nrm(6, (D_MODEL,)),
        "w_in": nrm(7, (DEPTH, D_MODEL, N_IN)) * D_MODEL ** -0.5 * col_scale,
        "b_f": 0.1 * nrm(8, (DEPTH, H_A * DK)),
        "lb_param": 0.1 * nrm(9, (DEPTH + 1, H_A * DK)),
        "gnorm_g": 1.0 + 0.02 * nrm(10, (DEPTH, H_A * DV)),
        "conv_w": nrm(11, (DEPTH, CONV_W, D_B)) * CONV_W ** -0.5,
        "w_o": nrm(12, (DEPTH, D_MODEL, D_MODEL)) * D_MODEL ** -0.5 * BETA,
        "ln1_g": 1.0 + 0.02 * nrm(13, (DEPTH, D_MODEL)),
        "ln1_b": 0.02 * nrm(14, (DEPTH, D_MODEL)),
        "w_gate": nrm(15, (DEPTH, D_MODEL, D_FF)) * D_MODEL ** -0.5,
        "w_up": nrm(16, (DEPTH, D_MODEL, D_FF)) * D_MODEL ** -0.5,
        "w_down": nrm(17, (DEPTH, D_FF, D_MODEL)) * D_FF ** -0.5 * BETA,
        "ln2_g": 1.0 + 0.02 * nrm(18, (DEPTH, D_MODEL)),
        "ln2_b": 0.02 * nrm(19, (DEPTH, D_MODEL)),
    }


def reference(x_prompt, x_sample, state_hgrn, state_conv, meta_tokens, ln0_g, ln0_b,
              w_in, b_f, lb_param, gnorm_g, conv_w, w_o, ln1_g, ln1_b,
              w_gate, w_up, w_down, ln2_g, ln2_b):
    f32 = jnp.float32
    lbs = jnp.cumsum(jax.nn.softmax(lb_param.astype(f32), axis=0), axis=0)

    meta = jnp.broadcast_to(meta_tokens.astype(x_prompt.dtype)[None], (x_prompt.shape[0], N_META, D_MODEL))
    xp = _layernorm(jnp.concatenate([meta, x_prompt], axis=1), ln0_g, ln0_b)
    xs = _layernorm(x_sample, ln0_g, ln0_b)
    bp = x_prompt.shape[0]

    hp, cp, hs, cs = [], [], [], []
    for l in range(DEPTH):
        w = (lbs[l], w_in[l], b_f[l], gnorm_g[l], conv_w[l], w_o[l],
             ln1_g[l], ln1_b[l], w_gate[l], w_up[l], w_down[l], ln2_g[l], ln2_b[l])
        S0p = jnp.zeros((bp, H_A, DK, DV), f32)
        buf0p = jnp.zeros((bp, CONV_W - 1, D_B), xp.dtype)
        xp, Sp, bufp = _layer(xp, S0p, buf0p, N_META, *w)
        xs, Ss, bufs = _layer(xs, state_hgrn[l], state_conv[l], 0, *w)
        hp.append(Sp); cp.append(bufp); hs.append(Ss); cs.append(bufs)

    y_prompt = xp[:, N_META:]
    y_sample = xs
    return (y_prompt, y_sample, jnp.stack(hp), jnp.stack(cp), jnp.stack(hs), jnp.stack(cs))
```

```cpp
#include <hip/hip_runtime.h>
#include <hip/hip_cooperative_groups.h>
#include <cstdio>
namespace cg = cooperative_groups;

#ifndef N_LAUNCH_MODE
#define N_LAUNCH_MODE 0
#endif

#define LAS __attribute__((address_space(3)))
typedef unsigned short bf16_t;
typedef short bf16x8 __attribute__((ext_vector_type(8)));
typedef float f32x4 __attribute__((ext_vector_type(4)));
typedef float f32x2 __attribute__((ext_vector_type(2)));
typedef unsigned u32x4 __attribute__((ext_vector_type(4)));
typedef unsigned u32x2 __attribute__((ext_vector_type(2)));

constexpr int D = 2048, NIN = 7168, DFF = 5632, NGU = 11264;
constexpr int LP = 2064, MPR = 8256, MTOK = 8768, MPAD = 8960;
constexpr int NCH = 33, NITEM_P = 4 * 8 * NCH, NITEM_S = 128 * 8;
constexpr float ALPHA = 1.18920711500272f;
constexpr float LN_EPS = 1e-5f, RMS_EPS = 1e-6f;

constexpr size_t SZ2K = (size_t)MPAD * 2048 * 2, SZ1K = (size_t)MPAD * 1024 * 2;
constexpr size_t OFF_WIN = 0;
constexpr size_t OFF_WO = OFF_WIN + (size_t)NIN * D * 2;
constexpr size_t OFF_WGU = OFF_WO + (size_t)D * D * 2;
constexpr size_t OFF_XN = OFF_WGU + (size_t)NGU * D * 2;
constexpr size_t OFF_A2 = OFF_XN + SZ2K;
constexpr size_t OFF_PROJ = OFF_A2 + SZ2K;
constexpr size_t OFF_QA = OFF_PROJ, OFF_KK = OFF_QA + SZ1K, OFF_V = OFF_KK + SZ1K, OFF_SG = OFF_V + SZ1K, OFF_GB = OFF_SG + SZ1K, OFF_U = OFF_GB + SZ1K, OFF_LF = OFF_U + SZ1K;
constexpr size_t OFF_T1 = OFF_PROJ, OFF_H = OFF_LF, OFF_ACT = OFF_PROJ, OFF_T2 = OFF_XN;
constexpr size_t OFF_UB = OFF_LF + (size_t)MPAD * 1024 * 4;
constexpr size_t OFF_DB = OFF_UB + (size_t)NITEM_P * 16384 * 2;
constexpr size_t OFF_BAR = OFF_DB + (size_t)NITEM_P * 128 * 4;
constexpr size_t WS_END = OFF_BAR + 16384;
static_assert((size_t)MPAD * DFF * 2 <= 6 * SZ1K, "ACT must not reach H");

constexpr int TPB = 2048 + 64;
constexpr int TP = 2048 + 64;
constexpr size_t SLAB_FLOATS = (size_t)(MTOK - 8192) * TP;
constexpr size_t SLAB_ELEMS = (size_t)(MTOK - 8192) * TPB;
constexpr size_t OFF_SLAB2 = OFF_T1 + (size_t)MPAD * 2048 * 4;
constexpr size_t OFF_SLAB4 = OFF_WO;
static_assert(OFF_SLAB2 + 4 * SLAB_FLOATS * 4 <= OFF_H && OFF_SLAB4 + 9 * SLAB_FLOATS * 4 <= OFF_XN && (size_t)8192 * TP * 4 <= 2 * SZ2K, "slabs / T pitch");
constexpr size_t O_YP = 0, O_YS = 16777216, O_HP = O_YS + 1048576, O_CP = O_HP + 524288, O_HS = O_CP + 8192, O_CS = O_HS + 16777216;

struct Params { const float* in[20]; float* out; unsigned char* ws; int ph_lo, ph_hi; };

typedef __bf16 bf2_t __attribute__((ext_vector_type(2)));
__device__ __forceinline__ unsigned pk2(float lo, float hi) { const f32x2 v = {lo, hi}; const bf2_t b = __builtin_convertvector(v, bf2_t); return __builtin_bit_cast(unsigned, b); }
__device__ __forceinline__ float bf2f(bf16_t v) { return __uint_as_float(((unsigned)v) << 16); }
__device__ __forceinline__ float bflo(unsigned w) { return __uint_as_float(w << 16); }
__device__ __forceinline__ float bfhi(unsigned w) { return __uint_as_float(w & 0xffff0000u); }
__device__ __forceinline__ float fexp(float x) { return __expf(x); }
__device__ __forceinline__ float frcp(float x) { return __builtin_amdgcn_rcpf(x); }
__device__ __forceinline__ float silu(float x) { return x * frcp(1.0f + fexp(-x)); }
__device__ __forceinline__ float wave_sum(float v) {
#pragma unroll
    for (int o = 1; o < 64; o <<= 1) v += __shfl_xor(v, o);
    return v;
}
#define LDS_WAIT() asm volatile("s_waitcnt lgkmcnt(0)" ::: "memory")

namespace pg8 {
constexpr int BM = 256, BK = 64, HALF = 128, HTB = HALF * BK * 2, STAGE_BYTES = 8 * HTB, NXCD = 8, WGM = 8;
__host__ __device__ __forceinline__ int lds_byte(int r, int c) { const int st = (r >> 4) * 2 + (c >> 5), rr = r & 15, cc = c & 31, ob = rr * 64 + cc * 2; return st * 1024 + (ob ^ (((ob >> 9) & 1) << 5)); }
__host__ __device__ __forceinline__ void stage_rc(int b, int& R, int& C) { const int st = b / 1024, sb = b % 1024, swz = sb ^ (((sb >> 9) & 1) << 5); R = (st >> 1) * 16 + swz / 64; C = (st & 1) * 32 + (swz % 64) / 2; }
__host__ __device__ __forceinline__ int perm32(int rho) { const int n = rho >> 4, i = rho & 15; return 8 * (i >> 2) + 4 * n + (i & 3); }

struct Unit { int pm, pn, kt0, nt, part; };
struct Gemm { const bf16_t* A; const bf16_t* Bt; int M, N, K; };

struct StaticOrder {
    int nM, nN, nwg, G, c, NT;
    __device__ void init(int M, int N, int K, int G_, int c_) { nM = M / BM; nN = N / BM; nwg = nM * nN; G = G_; c = c_; NT = K / BK; }
    __device__ __forceinline__ bool next(int i, Unit& u) const {
        const long L = (long)i * G + c; if (L >= nwg) return false;
        u.kt0 = 0; u.nt = NT; u.part = -1;
        int wgid = (int)L; { const int q = nwg / NXCD, r = nwg % NXCD, xcd = wgid % NXCD, off = wgid / NXCD; wgid = (xcd < r ? xcd * (q + 1) : r * (q + 1) + (xcd - r) * q) + off; }
        const int nig = WGM * nN, gid = wgid / nig, fm = gid * WGM, gsz = (nM - fm) < WGM ? (nM - fm) : WGM;
        u.pm = fm + ((wgid % nig) % gsz); u.pn = (wgid % nig) / gsz; return true;
    }
};

struct TailOrder {
    StaticOrder so; int PLEN, PPU, NP;
    __device__ void init(int K, int G_, int c_, int plen) { so.init(8192, 2048, K, G_, c_); PLEN = plen; PPU = (so.NT + plen - 1) / plen; NP = 24 * PPU; }
    __device__ __forceinline__ bool next(int i, Unit& u) const {
        Unit f; f.pm = 0; f.pn = 0; f.kt0 = 0; f.nt = so.NT; f.part = -1; const bool isf = so.next(i, f);
        const long p = (long)i * so.G + so.c - so.nwg; const bool isp = !isf && p < NP;
        const int pp = isp ? (int)p : 0, t = pp / PPU, piece = pp - t * PPU, kt0 = piece * PLEN, rem = so.NT - kt0;
        u.pm = isf ? f.pm : 32 + (t >> 3); u.pn = isf ? f.pn : (t & 7); u.kt0 = isf ? 0 : kt0; u.nt = isf ? so.NT : (rem < PLEN ? rem : PLEN); u.part = isf ? -1 : piece;
        return isf || isp;
    }
};

template <class Epi, class Order>
__device__ __forceinline__ void gemm_phase(LAS unsigned char* lds, const Gemm g, const Order& S, const Epi& E) {
    const int tid = threadIdx.x, wid = __builtin_amdgcn_readfirstlane(tid >> 6), lane = tid & 63, wr = wid >> 2, wc = wid & 3, fr = lane & 15, fq = lane >> 4;
    const int K = g.K;
    unsigned voffA[2], voffB[2];
#pragma unroll
    for (int i = 0; i < 2; ++i) { int R, C; stage_rc(tid * 16 + i * 8192, R, C); const int Rb = Epi::PERM ? ((R & ~31) + perm32(R & 31)) : R;
        voffA[i] = (unsigned)(R * K + C) * 2u; voffB[i] = (unsigned)(Rb * K + C) * 2u; }
    const size_t kstep = (size_t)(BK * 2);
    const size_t hstep = (size_t)HALF * K * 2;
    const size_t tstep = 2 * hstep;
    const unsigned ldsw = (unsigned)wid * 1024u;
    const int aoff = lds_byte(wr * 64 + fr, fq * 8), boff = lds_byte(wc * 32 + fr, fq * 8);
#define PG8_SA(b, h) (((b) * 2 + (h)) * HTB)
#define PG8_SB(b, h) ((4 + (b) * 2 + (h)) * HTB)
#define PG8_STAGE(bufoff, gbase, voff) do { _Pragma("unroll") for (int _i = 0; _i < 2; ++_i) \
        __builtin_amdgcn_global_load_lds((const unsigned*)((const char*)(gbase) + (voff)[_i]), (LAS unsigned*)(lds + (bufoff) + ldsw + _i * 8192), 16, 0, 0); } while (0)
#define PG8_LDA(dst, b, h) do { _Pragma("unroll") for (int m = 0; m < 4; ++m) _Pragma("unroll") for (int k = 0; k < 2; ++k) dst[m][k] = *(const LAS bf16x8*)(lds + PG8_SA(b, h) + aoff + m * 2048 + k * 1024); } while (0)
#define PG8_LDB(dst, b, h) do { _Pragma("unroll") for (int n = 0; n < 2; ++n) _Pragma("unroll") for (int k = 0; k < 2; ++k) dst[n][k] = *(const LAS bf16x8*)(lds + PG8_SB(b, h) + boff + n * 2048 + k * 1024); } while (0)
#define PG8_MMA(ai, bj, At, Bt) do { __builtin_amdgcn_s_setprio(1); _Pragma("unroll") for (int m = 0; m < 4; ++m) _Pragma("unroll") for (int n = 0; n < 2; ++n) _Pragma("unroll") for (int k = 0; k < 2; ++k) \
        acc[ai][bj][m][n] = __builtin_amdgcn_mfma_f32_16x16x32_bf16(Bt[n][k], At[m][k], acc[ai][bj][m][n], 0, 0, 0); __builtin_amdgcn_s_setprio(0); } while (0)
#define PG8_WAIT_V(n) asm volatile("s_waitcnt vmcnt(" #n ")" ::: "memory")
#define PG8_WAIT_L(n) asm volatile("s_waitcnt lgkmcnt(" #n ")" ::: "memory")
#define PG8_BAR __builtin_amdgcn_s_barrier()
#define PG8_SCHED __builtin_amdgcn_sched_barrier(0)
    Unit cur, nxt; int ui = 0;
    if (!S.next(0, cur)) return;
    f32x4 acc[2][2][4][2];
#pragma unroll
    for (int a = 0; a < 2; ++a)
#pragma unroll
        for (int b = 0; b < 2; ++b)
#pragma unroll
            for (int m = 0; m < 4; ++m)
#pragma unroll
                for (int n = 0; n < 2; ++n) acc[a][b][m][n] = (f32x4){0.f, 0.f, 0.f, 0.f};
    bf16x8 At[4][2], B0[2][2], B1[2][2];
    const char* cA = (const char*)g.A + (size_t)cur.pm * tstep + (size_t)cur.kt0 * kstep; const char* cB = (const char*)g.Bt + (size_t)cur.pn * tstep + (size_t)cur.kt0 * kstep;
    PG8_STAGE(PG8_SB(0, 0), cB, voffB); PG8_STAGE(PG8_SA(0, 0), cA, voffA); PG8_STAGE(PG8_SB(0, 1), cB + hstep, voffB); PG8_STAGE(PG8_SA(0, 1), cA + hstep, voffA);
    if (wr == 1) PG8_BAR;
    PG8_WAIT_V(4); PG8_BAR;
    PG8_STAGE(PG8_SB(1, 0), cB + kstep, voffB); PG8_STAGE(PG8_SA(1, 0), cA + kstep, voffA); PG8_STAGE(PG8_SB(1, 1), cB + hstep + kstep, voffB);
    PG8_WAIT_V(6); PG8_BAR;
    for (;;) {
        const bool has_next = S.next(ui + 1, nxt);
        const char* nA = has_next ? (const char*)g.A + (size_t)nxt.pm * tstep + (size_t)nxt.kt0 * kstep : cA; const char* nB = has_next ? (const char*)g.Bt + (size_t)nxt.pn * tstep + (size_t)nxt.kt0 * kstep : cB;
        const int nt = cur.nt;
        for (int t = 0; t < nt; t += 2) {
            const bool last = (t == nt - 2);
            const char* a1 = cA + (size_t)(t + 1) * kstep;
            const char* a2 = last ? nA : cA + (size_t)(t + 2) * kstep; const char* b2 = last ? nB : cB + (size_t)(t + 2) * kstep;
            const char* a3 = a2 + kstep; const char* b3 = b2 + kstep;
            PG8_LDB(B0, 0, 0); PG8_SCHED; PG8_LDA(At, 0, 0); PG8_STAGE(PG8_SA(1, 1), a1 + hstep, voffA);
            PG8_WAIT_L(8); PG8_BAR; PG8_WAIT_L(0); PG8_MMA(0, 0, At, B0); PG8_BAR; PG8_SCHED;
            PG8_LDB(B1, 0, 1); PG8_STAGE(PG8_SB(0, 0), b2, voffB);
            PG8_BAR; PG8_WAIT_L(0); PG8_MMA(0, 1, At, B1); PG8_BAR;
            PG8_LDA(At, 0, 1); PG8_STAGE(PG8_SA(0, 0), a2, voffA);
            PG8_BAR; PG8_WAIT_L(0); PG8_MMA(1, 0, At, B0); PG8_BAR; PG8_SCHED;
            PG8_STAGE(PG8_SB(0, 1), b2 + hstep, voffB);
            PG8_WAIT_V(6); PG8_BAR; PG8_MMA(1, 1, At, B1); PG8_BAR;
            PG8_LDB(B0, 1, 0); PG8_SCHED; PG8_LDA(At, 1, 0); PG8_STAGE(PG8_SA(0, 1), a2 + hstep, voffA);
            PG8_WAIT_L(8); PG8_BAR; PG8_WAIT_L(0); PG8_MMA(0, 0, At, B0); PG8_BAR; PG8_SCHED;
            PG8_LDB(B1, 1, 1); PG8_STAGE(PG8_SB(1, 0), b3, voffB);
            PG8_BAR; PG8_WAIT_L(0); PG8_MMA(0, 1, At, B1); PG8_BAR;
            PG8_LDA(At, 1, 1); PG8_STAGE(PG8_SA(1, 0), a3, voffA);
            PG8_BAR; PG8_WAIT_L(0); PG8_MMA(1, 0, At, B0); PG8_BAR; PG8_SCHED;
            PG8_STAGE(PG8_SB(1, 1), b3 + hstep, voffB);
            PG8_WAIT_V(6); PG8_BAR; PG8_MMA(1, 1, At, B1); PG8_BAR;
        }
        E(acc, cur, wr, wc, fr, fq);
        if (!has_next) break;
#pragma unroll
        for (int a = 0; a < 2; ++a)
#pragma unroll
            for (int b = 0; b < 2; ++b)
#pragma unroll
                for (int m = 0; m < 4; ++m)
#pragma unroll
                    for (int n = 0; n < 2; ++n) acc[a][b][m][n] = (f32x4){0.f, 0.f, 0.f, 0.f};
        cur = nxt; cA = nA; cB = nB; ++ui;
    }
    PG8_WAIT_V(0);
    if (wr == 0) PG8_BAR;
    PG8_BAR;
#undef PG8_SA
#undef PG8_SB
#undef PG8_STAGE
#undef PG8_LDA
#undef PG8_LDB
#undef PG8_MMA
#undef PG8_WAIT_V
#undef PG8_WAIT_L
#undef PG8_BAR
#undef PG8_SCHED
}
}

struct EpiProj {
    static constexpr bool PERM = true;
    bf16_t *QA, *KK, *V, *SG, *GB, *U; float* LF; const float* b_f; const float* lbp;
    __device__ __forceinline__ void operator()(const f32x4 (&acc)[2][2][4][2], const pg8::Unit& u, int wr, int wc, int fr, int fq) const {
        const int row0 = u.pm * 256 + wr * 64 + fr;
        if (u.pn >= 20) {
            const int c0 = (u.pn - 20) * 128 + wc * 32 + 8 * fq;
#pragma unroll
            for (int ai = 0; ai < 2; ++ai)
#pragma unroll
                for (int m = 0; m < 4; ++m) { const size_t row = row0 + ai * 128 + m * 16;
                    const f32x4 a = acc[ai][0][m][0] * acc[ai][1][m][0], b = acc[ai][0][m][1] * acc[ai][1][m][1];
                    u32x4 w; w.x = pk2(a[0], a[1]); w.y = pk2(a[2], a[3]); w.z = pk2(b[0], b[1]); w.w = pk2(b[2], b[3]);
                    *(u32x4*)(U + row * 1024 + c0) = w; }
            return;
        }
        const int seg = u.pn >> 2;
        if (seg == 1) {
#pragma unroll
            for (int bj = 0; bj < 2; ++bj) { const int c0 = (u.pn - 4) * 256 + bj * 128 + wc * 32 + 8 * fq;
                float bf[8], oml[8];
#pragma unroll
                for (int j = 0; j < 8; ++j) { bf[j] = b_f[c0 + j]; const float lb = frcp(1.0f + fexp(lbp[1024 + c0 + j] - lbp[c0 + j])); oml[j] = 1.0f - lb; }
#pragma unroll
                for (int ai = 0; ai < 2; ++ai)
#pragma unroll
                    for (int m = 0; m < 4; ++m) { const size_t row = row0 + ai * 128 + m * 16; float kk[8], lf[8];
#pragma unroll
                        for (int n = 0; n < 2; ++n)
#pragma unroll
                            for (int j = 0; j < 4; ++j) { const float z = acc[ai][bj][m][n][j] + bf[4 * n + j]; const float k = oml[4 * n + j] * frcp(1.0f + fexp(z)); kk[4 * n + j] = k; lf[4 * n + j] = __logf(1.0f - k); }
                        u32x4 w; w.x = pk2(kk[0], kk[1]); w.y = pk2(kk[2], kk[3]); w.z = pk2(kk[4], kk[5]); w.w = pk2(kk[6], kk[7]);
                        *(u32x4*)(KK + row * 1024 + c0) = w;
                        *(f32x4*)(LF + row * 1024 + c0) = (f32x4){lf[0], lf[1], lf[2], lf[3]}; *(f32x4*)(LF + row * 1024 + c0 + 4) = (f32x4){lf[4], lf[5], lf[6], lf[7]}; }
            }
            return;
        }
        bf16_t* dst = seg == 0 ? QA : (seg == 2 ? V : (seg == 3 ? SG : GB));
        const bool act = (seg == 0 || seg == 3);
#pragma unroll
        for (int bj = 0; bj < 2; ++bj) { const int c0 = (u.pn & 3) * 256 + bj * 128 + wc * 32 + 8 * fq;
#pragma unroll
            for (int ai = 0; ai < 2; ++ai)
#pragma unroll
                for (int m = 0; m < 4; ++m) { const size_t row = row0 + ai * 128 + m * 16; f32x4 a = acc[ai][bj][m][0], b = acc[ai][bj][m][1];
                    if (act) {
#pragma unroll
                        for (int j = 0; j < 4; ++j) { a[j] = silu(a[j]); b[j] = silu(b[j]); } }
                    u32x4 w; w.x = pk2(a[0], a[1]); w.y = pk2(a[2], a[3]); w.z = pk2(b[0], b[1]); w.w = pk2(b[2], b[3]);
                    *(u32x4*)(dst + row * 1024 + c0) = w; }
        }
    }
};
struct EpiRes {
    static constexpr bool PERM = true;
    bf16_t* T; bf16_t* slab;
    __device__ __forceinline__ void operator()(const f32x4 (&acc)[2][2][4][2], const pg8::Unit& u, int wr, int wc, int fr, int fq) const {
        const int row0 = u.pm * 256 + wr * 64 + fr, col0 = u.pn * 256 + wc * 32 + 8 * fq;
        if (u.part >= 0) {
            bf16_t* S = slab + (size_t)u.part * SLAB_ELEMS;
#pragma unroll
            for (int ai = 0; ai < 2; ++ai)
#pragma unroll
                for (int m = 0; m < 4; ++m) { const int row = row0 + ai * 128 + m * 16; if (row < MTOK) { bf16_t* p = S + (size_t)(row - 8192) * TPB + col0;
#pragma unroll
                    for (int bj = 0; bj < 2; ++bj) { const f32x4 a = acc[ai][bj][m][0], b = acc[ai][bj][m][1];
                        u32x4 w; w.x = pk2(a[0], a[1]); w.y = pk2(a[2], a[3]); w.z = pk2(b[0], b[1]); w.w = pk2(b[2], b[3]);
                        *(u32x4*)(p + bj * 128) = w; } } }
            return;
        }
#pragma unroll
        for (int ai = 0; ai < 2; ++ai)
#pragma unroll
            for (int m = 0; m < 4; ++m) { bf16_t* p = T + (size_t)(row0 + ai * 128 + m * 16) * TPB + col0;
#pragma unroll
                for (int bj = 0; bj < 2; ++bj) { const f32x4 a = acc[ai][bj][m][0], b = acc[ai][bj][m][1];
                    u32x4 w; w.x = pk2(a[0], a[1]); w.y = pk2(a[2], a[3]); w.z = pk2(b[0], b[1]); w.w = pk2(b[2], b[3]);
                    *(u32x4*)(p + bj * 128) = w; } }
    }
};
struct EpiGLU {
    static constexpr bool PERM = true;
    bf16_t* ACT;
    __device__ __forceinline__ void operator()(const f32x4 (&acc)[2][2][4][2], const pg8::Unit& u, int wr, int wc, int fr, int fq) const {
        const int row0 = u.pm * 256 + wr * 64 + fr, c0 = u.pn * 128 + wc * 32 + 8 * fq;
#pragma unroll
        for (int ai = 0; ai < 2; ++ai)
#pragma unroll
            for (int m = 0; m < 4; ++m) { const size_t row = row0 + ai * 128 + m * 16; f32x4 a, b;
#pragma unroll
                for (int j = 0; j < 4; ++j) { a[j] = silu(acc[ai][0][m][0][j]) * acc[ai][1][m][0][j]; b[j] = silu(acc[ai][0][m][1][j]) * acc[ai][1][m][1][j]; }
                u32x4 w; w.x = pk2(a[0], a[1]); w.y = pk2(a[2], a[3]); w.z = pk2(b[0], b[1]); w.w = pk2(b[2], b[3]);
                *(u32x4*)(ACT + row * DFF + c0) = w; }
    }
};

__device__ __forceinline__ void cvt_item(const float* W, int N, bf16_t* WT, int K, int dst_row0, int k0, int n0, LAS float* scr, int lane) {
#pragma unroll 8
    for (int i = 0; i < 32; ++i) { const int kk = 2 * i + (lane >> 5); scr[kk * 33 + (lane & 31)] = W[(size_t)(k0 + kk) * N + n0 + (lane & 31)]; }
    LDS_WAIT();
    const int c = lane & 7;
#pragma unroll
    for (int j = 0; j < 4; ++j) { const int n = (lane >> 3) + 8 * j; const LAS float* s = scr + (8 * c) * 33 + n;
        u32x4 o; o.x = pk2(s[0 * 33], s[1 * 33]); o.y = pk2(s[2 * 33], s[3 * 33]); o.z = pk2(s[4 * 33], s[5 * 33]); o.w = pk2(s[6 * 33], s[7 * 33]);
        *(u32x4*)(WT + (size_t)(dst_row0 + n) * K + k0 + 8 * c) = o; }
    LDS_WAIT();
}
__device__ __forceinline__ int map_win(int n0) { if (n0 < 5120) return n0; const int j = n0 - 5120, which = j >> 10, jj = j & 1023; return 5120 + (jj >> 7) * 256 + which * 128 + (jj & 127); }
__device__ __forceinline__ int map_gu(int n0, int which) { return (n0 >> 7) * 256 + which * 128 + (n0 & 127); }

__device__ __forceinline__ void ln_row_load(const float* xrow, int lane, f32x4 (&v)[8], float& mean, float& rstd) {
    const f32x4* xr = (const f32x4*)xrow + lane; float s = 0.f;
#pragma unroll
    for (int j = 0; j < 8; ++j) { v[j] = xr[64 * j]; s += (v[j][0] + v[j][1]) + (v[j][2] + v[j][3]); }
    mean = wave_sum(s) * (1.f / 2048.f); float s2 = 0.f;
#pragma unroll
    for (int j = 0; j < 8; ++j) { v[j] = v[j] - mean; s2 += (v[j][0] * v[j][0] + v[j][1] * v[j][1]) + (v[j][2] * v[j][2] + v[j][3] * v[j][3]); }
    rstd = 1.0f / sqrtf(wave_sum(s2) * (1.f / 2048.f) + LN_EPS);
}
__device__ __forceinline__ void ln_stats(int lane, f32x4 (&v)[8], float& mean, float& rstd) {
    float s = 0.f;
#pragma unroll
    for (int j = 0; j < 8; ++j) s += (v[j][0] + v[j][1]) + (v[j][2] + v[j][3]);
    mean = wave_sum(s) * (1.f / 2048.f); float s2 = 0.f;
#pragma unroll
    for (int j = 0; j < 8; ++j) { v[j] = v[j] - mean; s2 += (v[j][0] * v[j][0] + v[j][1] * v[j][1]) + (v[j][2] * v[j][2] + v[j][3] * v[j][3]); }
    rstd = 1.0f / sqrtf(wave_sum(s2) * (1.f / 2048.f) + LN_EPS);
}
__device__ __forceinline__ void ln_row_load_res(const bf16_t* trow, const bf16_t* resrow, int lane, f32x4 (&v)[8], float& mean, float& rstd) {
#pragma unroll
    for (int j = 0; j < 8; ++j) { const u32x2 r = ((const u32x2*)resrow)[lane + 64 * j]; const u32x2 t = ((const u32x2*)trow)[lane + 64 * j];
        v[j] = (f32x4){ALPHA * bflo(r.x) + bflo(t.x), ALPHA * bfhi(r.x) + bfhi(t.x), ALPHA * bflo(r.y) + bflo(t.y), ALPHA * bfhi(r.y) + bfhi(t.y)}; }
    ln_stats(lane, v, mean, rstd);
}
template <int NPARTS> __device__ __forceinline__ void ln_row_load_tail(const bf16_t* slab, int rowt, const bf16_t* resrow, int lane, f32x4 (&v)[8], float& mean, float& rstd) {
#pragma unroll
    for (int j = 0; j < 8; ++j) { const u32x2 r = ((const u32x2*)resrow)[lane + 64 * j]; v[j] = (f32x4){ALPHA * bflo(r.x), ALPHA * bfhi(r.x), ALPHA * bflo(r.y), ALPHA * bfhi(r.y)}; }
#pragma unroll
    for (int p = 0; p < NPARTS; ++p) { const u32x2* sp = (const u32x2*)(slab + (size_t)p * SLAB_ELEMS + (size_t)rowt * TPB) + lane;
#pragma unroll
        for (int j = 0; j < 8; ++j) { const u32x2 t = sp[64 * j]; v[j] += (f32x4){bflo(t.x), bfhi(t.x), bflo(t.y), bfhi(t.y)}; } }
    ln_stats(lane, v, mean, rstd);
}
__device__ __forceinline__ void ln_store_bf16(const f32x4 (&v)[8], float rstd, const float* g, const float* b, bf16_t* orow, int lane) {
    u32x2* o8 = (u32x2*)orow + lane;
#pragma unroll
    for (int j = 0; j < 8; ++j) { const f32x4 gg = ((const f32x4*)g)[lane + 64 * j], bb = ((const f32x4*)b)[lane + 64 * j]; const f32x4 y = v[j] * rstd * gg + bb;
        u32x2 w; w.x = pk2(y[0], y[1]); w.y = pk2(y[2], y[3]); o8[64 * j] = w; }
}
__device__ __forceinline__ void ln_store_f32(const f32x4 (&v)[8], float rstd, const float* g, const float* b, float* orow, int lane) {
    f32x4* o = (f32x4*)orow + lane;
#pragma unroll
    for (int j = 0; j < 8; ++j) { const f32x4 gg = ((const f32x4*)g)[lane + 64 * j], bb = ((const f32x4*)b)[lane + 64 * j]; o[64 * j] = v[j] * rstd * gg + bb; }
}
__device__ __forceinline__ void ln_row_bf16(const float* xrow, const float* g, const float* b, bf16_t* orow, int lane) {
    f32x4 v[8]; float mean, rstd; ln_row_load(xrow, lane, v, mean, rstd);
    u32x2* o8 = (u32x2*)orow + lane;
#pragma unroll
    for (int j = 0; j < 8; ++j) { const f32x4 gg = ((const f32x4*)g)[lane + 64 * j], bb = ((const f32x4*)b)[lane + 64 * j]; const f32x4 y = v[j] * rstd * gg + bb;
        u32x2 w; w.x = pk2(y[0], y[1]); w.y = pk2(y[2], y[3]); o8[64 * j] = w; }
}
__device__ __forceinline__ void ln_row_f32(const float* xrow, const float* g, const float* b, float* orow, int lane) {
    f32x4 v[8]; float mean, rstd; ln_row_load(xrow, lane, v, mean, rstd);
    f32x4* o = (f32x4*)orow + lane;
#pragma unroll
    for (int j = 0; j < 8; ++j) { const f32x4 gg = ((const f32x4*)g)[lane + 64 * j], bb = ((const f32x4*)b)[lane + 64 * j]; o[64 * j] = v[j] * rstd * gg + bb; }
}

__device__ __forceinline__ void phase0(const Params& P, LAS unsigned char* lds) {
    const int tid = threadIdx.x, lane = tid & 63, wave = tid >> 6, gw = blockIdx.x * 8 + wave, NGW = gridDim.x * 8;
    LAS float* scr = (LAS float*)(lds + wave * 8704);
    unsigned char* ws = P.ws;
    constexpr int I_IN = 32 * 224, I_O = 32 * 64, I_G = 32 * 176;
    for (int it = gw; it < I_IN + I_O + 2 * I_G; it += NGW) {
        int r = it;
        if (r < I_IN) { const int kb = r / 224, nb = r % 224; cvt_item(P.in[7], NIN, (bf16_t*)(ws + OFF_WIN), D, map_win(nb * 32), kb * 64, nb * 32, scr, lane); continue; } r -= I_IN;
        if (r < I_O) { const int kb = r / 64, nb = r % 64; cvt_item(P.in[12], D, (bf16_t*)(ws + OFF_WO), D, nb * 32, kb * 64, nb * 32, scr, lane); continue; } r -= I_O;
        if (r < I_G) { const int kb = r / 176, nb = r % 176; cvt_item(P.in[15], DFF, (bf16_t*)(ws + OFF_WGU), D, map_gu(nb * 32, 0), kb * 64, nb * 32, scr, lane); continue; } r -= I_G;
        { const int kb = r / 176, nb = r % 176; cvt_item(P.in[16], DFF, (bf16_t*)(ws + OFF_WGU), D, map_gu(nb * 32, 1), kb * 64, nb * 32, scr, lane); }
    }
    bf16_t* XN = (bf16_t*)(ws + OFF_XN);
    for (int r = gw; r < MPAD; r += NGW) {
        if (r >= MTOK) { u32x2* o8 = (u32x2*)(XN + (size_t)r * D) + lane;
#pragma unroll
            for (int j = 0; j < 8; ++j) o8[64 * j] = (u32x2){0u, 0u};
            continue; }
        const float* src;
        if (r < MPR) { const int b = r / LP, t = r % LP; src = t < 16 ? P.in[4] + (size_t)t * D : P.in[0] + ((size_t)b * 2048 + (t - 16)) * D; }
        else src = P.in[1] + (size_t)(r - MPR) * D;
        ln_row_bf16(src, P.in[5], P.in[6], XN + (size_t)r * D, lane);
    }
}

__device__ __forceinline__ void item_rows(int item, int& b, int& h, int& n, int& row0, int& cvalid) {
    b = item / (8 * NCH); const int rem = item % (8 * NCH); h = rem / NCH; n = rem % NCH;
    row0 = b * LP + (n == 0 ? 0 : 16 + (n - 1) * 64); cvalid = n == 0 ? 16 : 64;
}
__device__ __forceinline__ void p2a_item(const Params& P, LAS unsigned char* lds, int item) {
    unsigned char* ws = P.ws;
    const float* LF = (const float*)(ws + OFF_LF); const bf16_t* KK = (const bf16_t*)(ws + OFF_KK); const bf16_t* V = (const bf16_t*)(ws + OFF_V);
    bf16_t* UB = (bf16_t*)(ws + OFF_UB); float* DB = (float*)(ws + OFF_DB);
    int b, h, n, row0, cvalid; item_rows(item, b, h, n, row0, cvalid);
    LAS bf16_t* KdT = (LAS bf16_t*)lds; LAS bf16_t* VT = (LAS bf16_t*)(lds + 18432); LAS float* tot = (LAS float*)(lds + 36864);
    const int tid = threadIdx.x, k = tid & 127, tq = tid >> 7, lane = tid & 63, w = tid >> 6, fr = lane & 15, fq = lane >> 4;
    float lf[16], kv[16]; float run = 0.f;
#pragma unroll
    for (int i = 0; i < 16; ++i) { const int t = tq * 16 + i; const bool ok = t < cvalid; const size_t o = (size_t)(row0 + (ok ? t : cvalid - 1)) * 1024 + h * 128 + k;
        lf[i] = LF[o]; kv[i] = bf2f(KK[o]); if (!ok) { lf[i] = 0.f; kv[i] = 0.f; } }
    u32x4 vx[2];
#pragma unroll
    for (int r = 0; r < 2; ++r) { const int idx = tid + 512 * r, t = idx >> 4, v8 = idx & 15; const bool ok = t < cvalid;
        vx[r] = *(const u32x4*)(V + (size_t)(row0 + (ok ? t : cvalid - 1)) * 1024 + h * 128 + v8 * 8); if (!ok) vx[r] = (u32x4){0u, 0u, 0u, 0u}; }
#pragma unroll
    for (int i = 0; i < 16; ++i) { run += lf[i]; lf[i] = run; }
    tot[tq * 128 + k] = run;
#pragma unroll
    for (int r = 0; r < 2; ++r) { const int idx = tid + 512 * r, t = idx >> 4, v8 = idx & 15; const u32x4 x = vx[r];
        LAS bf16_t* d = VT + (v8 * 8) * 72 + (((t >> 3) ^ (v8 & 7)) << 3) + (t & 7);
        d[0 * 72] = (bf16_t)(x.x & 0xffff); d[1 * 72] = (bf16_t)(x.x >> 16); d[2 * 72] = (bf16_t)(x.y & 0xffff); d[3 * 72] = (bf16_t)(x.y >> 16);
        d[4 * 72] = (bf16_t)(x.z & 0xffff); d[5 * 72] = (bf16_t)(x.z >> 16); d[6 * 72] = (bf16_t)(x.w & 0xffff); d[7 * 72] = (bf16_t)(x.w >> 16); }
    __syncthreads();
    float off = 0.f, blast = 0.f;
#pragma unroll
    for (int q = 0; q < 4; ++q) { const float x = tot[q * 128 + k]; blast += x; if (q < tq) off += x; }
    { unsigned pw[8];
#pragma unroll
      for (int i = 0; i < 8; ++i) { const float k0 = kv[2 * i] * fexp(blast - (off + lf[2 * i])), k1 = kv[2 * i + 1] * fexp(blast - (off + lf[2 * i + 1])); pw[i] = pk2(k0, k1); }
      LAS u32x4* d = (LAS u32x4*)(KdT + k * 72 + tq * 16); d[0] = (u32x4){pw[0], pw[1], pw[2], pw[3]}; d[1] = (u32x4){pw[4], pw[5], pw[6], pw[7]}; }
    if (tq == 0) DB[(size_t)item * 128 + k] = fexp(blast);
    __syncthreads();
    {
        bf16x8 X[2];
#pragma unroll
        for (int ks = 0; ks < 2; ++ks) X[ks] = *(const LAS bf16x8*)(KdT + (w * 16 + fr) * 72 + ks * 32 + fq * 8);
        bf16_t* ub = UB + (size_t)item * 16384;
#pragma unroll
        for (int vt = 0; vt < 8; ++vt) { f32x4 acc = (f32x4){0.f, 0.f, 0.f, 0.f};
#pragma unroll
            for (int ks = 0; ks < 2; ++ks) { const int vr = vt * 16 + fr; const bf16x8 Y = *(const LAS bf16x8*)(VT + vr * 72 + (((ks * 4 + fq) ^ ((vr >> 3) & 7)) << 3)); acc = __builtin_amdgcn_mfma_f32_16x16x32_bf16(X[ks], Y, acc, 0, 0, 0); }
            u32x2 o; o.x = pk2(acc[0], acc[1]); o.y = pk2(acc[2], acc[3]);
            *(u32x2*)(ub + (vt * 16 + fr) * 128 + w * 16 + 4 * fq) = o; }
    }
    __syncthreads();
}
__device__ __forceinline__ void sample_item(const Params& P, LAS unsigned char* lds, int item) {
    unsigned char* ws = P.ws;
    const float* LF = (const float*)(ws + OFF_LF); const bf16_t* KK = (const bf16_t*)(ws + OFF_KK); const bf16_t* V = (const bf16_t*)(ws + OFF_V);
    const bf16_t* QA = (const bf16_t*)(ws + OFF_QA); const bf16_t* SG = (const bf16_t*)(ws + OFF_SG); bf16_t* A2 = (bf16_t*)(ws + OFF_A2);
    const int b = item >> 3, h = item & 7, r0 = MPR + b * 4, col = h * 128;
    LAS float* s_qd = (LAS float*)lds; LAS float* s_kd = s_qd + 512; LAS float* s_dec = s_kd + 512; LAS float* s_v = s_dec + 128; LAS float* s_ap = s_v + 512; LAS float* s_rms = s_ap + 32; LAS float* s_red = s_rms + 32;
    const int tid = threadIdx.x, lane = tid & 63, wave = tid >> 6;
    if (tid < 128) { const int k = tid; float bt[4], q[4], kk[4]; float run = 0.f;
#pragma unroll
        for (int t = 0; t < 4; ++t) { const size_t o = (size_t)(r0 + t) * 1024 + col + k; run += LF[o]; bt[t] = run; q[t] = bf2f(QA[o]); kk[t] = bf2f(KK[o]); }
#pragma unroll
        for (int t = 0; t < 4; ++t) { s_qd[t * 128 + k] = q[t] * fexp(bt[t]); s_kd[t * 128 + k] = kk[t] * fexp(bt[3] - bt[t]); }
        s_dec[k] = fexp(bt[3]);
#pragma unroll
        for (int t = 0; t < 4; ++t)
#pragma unroll
            for (int s = 0; s < 4; ++s) if (s <= t) { const float a = wave_sum(q[t] * kk[s] * fexp(bt[t] - bt[s])); if (lane == 0) s_ap[wave * 16 + t * 4 + s] = a; }
    } else if (tid < 256) { const int v = tid - 128;
#pragma unroll
        for (int t = 0; t < 4; ++t) s_v[t * 128 + v] = bf2f(V[(size_t)(r0 + t) * 1024 + col + v]); }
    __syncthreads();
    const float gn_pre = P.in[10][col + (tid & 127)], sg_pre = bf2f(SG[(size_t)(r0 + (tid >> 7)) * 1024 + col + (tid & 127)]);
    const int v4 = tid & 31, kg = tid >> 5;
    const float* S0p = P.in[2] + ((size_t)(b * 8 + h) * 128) * 128 + v4 * 4; float* Snp = P.out + O_HS + ((size_t)(b * 8 + h) * 128) * 128 + v4 * 4;
    f32x4 s0[8];
#pragma unroll
    for (int j = 0; j < 8; ++j) s0[j] = *(const f32x4*)(S0p + (size_t)(kg + 16 * j) * 128);
    f32x4 vv[4], o[4];
#pragma unroll
    for (int t = 0; t < 4; ++t) { vv[t] = *(const LAS f32x4*)(s_v + t * 128 + v4 * 4); o[t] = (f32x4){0.f, 0.f, 0.f, 0.f}; }
#pragma unroll
    for (int j = 0; j < 8; ++j) { const int k = kg + 16 * j; f32x4 sn = s0[j] * s_dec[k];
#pragma unroll
        for (int t = 0; t < 4; ++t) { sn += vv[t] * s_kd[t * 128 + k]; o[t] += s0[j] * s_qd[t * 128 + k]; }
        *(f32x4*)(Snp + (size_t)k * 128) = sn; }
#pragma unroll
    for (int t = 0; t < 4; ++t) *(LAS f32x4*)(s_red + (kg * 4 + t) * 128 + v4 * 4) = o[t];
    __syncthreads();
    { const int t = tid >> 7, v = tid & 127; float ov = 0.f;
#pragma unroll
      for (int g = 0; g < 16; ++g) ov += s_red[(g * 4 + t) * 128 + v];
#pragma unroll
      for (int s = 0; s < 4; ++s) if (s <= t) ov += (s_ap[t * 4 + s] + s_ap[16 + t * 4 + s]) * s_v[s * 128 + v];
      const float ss = wave_sum(ov * ov); if (lane == 0) s_rms[wave] = ss;
      __syncthreads();
      const float scale = 1.0f / sqrtf((s_rms[2 * t] + s_rms[2 * t + 1]) * (1.f / 128.f) + RMS_EPS);
      const float y = ov * scale * gn_pre * sg_pre;
      A2[(size_t)(r0 + t) * 2048 + col + v] = (bf16_t)(pk2(y, 0.f) & 0xffff); }
    __syncthreads();
}
__device__ __forceinline__ void unpack8(const u32x4 x, float (&f)[8]) { f[0] = bflo(x.x); f[1] = bfhi(x.x); f[2] = bflo(x.y); f[3] = bfhi(x.y); f[4] = bflo(x.z); f[5] = bfhi(x.z); f[6] = bflo(x.w); f[7] = bfhi(x.w); }
__device__ __forceinline__ void conv_phase(const Params& P) {
    unsigned char* ws = P.ws;
    const bf16_t* U = (const bf16_t*)(ws + OFF_U); const bf16_t* GB = (const bf16_t*)(ws + OFF_GB); bf16_t* A2 = (bf16_t*)(ws + OFF_A2);
    const float* cw = P.in[11]; const float* sc = P.in[3];
    const int gt = blockIdx.x * 512 + threadIdx.x, NT = gridDim.x * 512;
    for (int idx = gt; idx < MTOK * 128; idx += NT) {
        const int r = idx >> 7, c8 = (idx & 127) * 8;
        int t, L, bs; const bool samp = r >= MPR;
        if (!samp) { bs = r / LP; t = r - bs * LP; L = LP; } else { bs = (r - MPR) >> 2; t = (r - MPR) & 3; L = 4; }
        const u32x4 x2 = *(const u32x4*)(U + (size_t)r * 1024 + c8), xg = *(const u32x4*)(GB + (size_t)r * 1024 + c8);
        const u32x4 x1 = *(const u32x4*)(U + (size_t)(r >= 1 ? r - 1 : 0) * 1024 + c8), x0 = *(const u32x4*)(U + (size_t)(r >= 2 ? r - 2 : 0) * 1024 + c8);
        const f32x4 w0a = *(const f32x4*)(cw + c8), w0b = *(const f32x4*)(cw + c8 + 4), w1a = *(const f32x4*)(cw + 1024 + c8), w1b = *(const f32x4*)(cw + 1024 + c8 + 4), w2a = *(const f32x4*)(cw + 2048 + c8), w2b = *(const f32x4*)(cw + 2048 + c8 + 4);
        float u2[8], u1[8], u0[8], gb[8]; unpack8(x2, u2); unpack8(xg, gb); unpack8(x1, u1); unpack8(x0, u0);
        if (t < 2) {
            if (samp) { const float* s1 = sc + ((size_t)bs * 2 + 1) * 1024 + c8; const float* s0 = sc + ((size_t)bs * 2 + t) * 1024 + c8;
#pragma unroll
                for (int j = 0; j < 8; ++j) { if (t == 0) u1[j] = s1[j]; u0[j] = s0[j]; } }
            else {
#pragma unroll
                for (int j = 0; j < 8; ++j) { if (t == 0) u1[j] = 0.f; u0[j] = 0.f; } }
        }
        const float w0[8] = {w0a[0], w0a[1], w0a[2], w0a[3], w0b[0], w0b[1], w0b[2], w0b[3]}, w1[8] = {w1a[0], w1a[1], w1a[2], w1a[3], w1b[0], w1b[1], w1b[2], w1b[3]}, w2[8] = {w2a[0], w2a[1], w2a[2], w2a[3], w2b[0], w2b[1], w2b[2], w2b[3]};
        float y[8];
#pragma unroll
        for (int j = 0; j < 8; ++j) y[j] = gb[j] * (w0[j] * u0[j] + w1[j] * u1[j] + w2[j] * u2[j]);
        u32x4 w; w.x = pk2(y[0], y[1]); w.y = pk2(y[2], y[3]); w.z = pk2(y[4], y[5]); w.w = pk2(y[6], y[7]);
        *(u32x4*)(A2 + (size_t)r * 2048 + 1024 + c8) = w;
        if (t >= L - 2) { float* o = P.out + (samp ? O_CS : O_CP) + ((size_t)bs * 2 + (t - (L - 2))) * 1024 + c8;
            *(f32x4*)o = (f32x4){u2[0], u2[1], u2[2], u2[3]}; *(f32x4*)(o + 4) = (f32x4){u2[4], u2[5], u2[6], u2[7]}; }
    }
}

__device__ __forceinline__ void phase3(const Params& P) {
    unsigned char* ws = P.ws;
    bf16_t* UB = (bf16_t*)(ws + OFF_UB); const float* DB = (const float*)(ws + OFF_DB);
    for (int gt = blockIdx.x * 512 + threadIdx.x; gt < 131072; gt += gridDim.x * 512) {
        const int bh = gt >> 12, rem = gt & 4095, v = rem >> 5, k4 = rem & 31;
        bf16_t* base = UB + (size_t)bh * NCH * 16384 + v * 128 + k4 * 4; const float* dp = DB + (size_t)bh * NCH * 128 + k4 * 4;
        float S[4] = {0.f, 0.f, 0.f, 0.f};
#pragma unroll 11
        for (int n = 0; n < NCH; ++n) {
            const u32x2 x = *(const u32x2*)(base + (size_t)n * 16384); const f32x4 d0 = *(const f32x4*)(dp + n * 128);
            S[0] = d0[0] * S[0] + bflo(x.x); S[1] = d0[1] * S[1] + bfhi(x.x); S[2] = d0[2] * S[2] + bflo(x.y); S[3] = d0[3] * S[3] + bfhi(x.y);
            u32x2 w; w.x = pk2(S[0], S[1]); w.y = pk2(S[2], S[3]);
            *(u32x2*)(base + (size_t)n * 16384) = w;
        }
        float* o = P.out + O_HP + ((size_t)bh * 128 + k4 * 4) * 128 + v;
#pragma unroll
        for (int i = 0; i < 4; ++i) o[(size_t)i * 128] = S[i];
    }
}
__device__ __forceinline__ void cvt_wdown(const Params& P, LAS unsigned char* lds, int gw, int NGW) {
    const int lane = threadIdx.x & 63, wave = threadIdx.x >> 6;
    LAS float* scr = (LAS float*)(lds + wave * 8704);
    for (int it = gw; it < 88 * 64; it += NGW) { const int kb = it / 64, nb = it % 64; cvt_item(P.in[17], D, (bf16_t*)(P.ws + OFF_WIN), DFF, nb * 32, kb * 64, nb * 32, scr, lane); }
}

__device__ __forceinline__ void p2c_block(const Params& P, LAS unsigned char* lds, int first, int step) {
    unsigned char* ws = P.ws;
    const float* LF = (const float*)(ws + OFF_LF); const bf16_t* KK = (const bf16_t*)(ws + OFF_KK); const bf16_t* V = (const bf16_t*)(ws + OFF_V);
    const bf16_t* QA = (const bf16_t*)(ws + OFF_QA); const bf16_t* SG = (const bf16_t*)(ws + OFF_SG); bf16_t* A2 = (bf16_t*)(ws + OFF_A2);
    const bf16_t* UB = (const bf16_t*)(ws + OFF_UB);
    LAS bf16_t* Qt = (LAS bf16_t*)lds; LAS bf16_t* Kt = (LAS bf16_t*)(lds + 17408); LAS bf16_t* Qd = (LAS bf16_t*)(lds + 34816);
    LAS bf16_t* VT = (LAS bf16_t*)(lds + 52224); LAS bf16_t* Am = (LAS bf16_t*)(lds + 70656);
    LAS float* tot = (LAS float*)(lds + 79872); LAS float* bmid = (LAS float*)(lds + 81920); LAS float* rmsp = (LAS float*)(lds + 82432);
    const int tid = threadIdx.x, k = tid & 127, tq = __builtin_amdgcn_readfirstlane(tid >> 7), lane = tid & 63, w = __builtin_amdgcn_readfirstlane(tid >> 6), fr = lane & 15, fq = lane >> 4;
    const int tt = w & 3, vh = w >> 2;
    float lfr[16]; bf16_t kr[16], qr[16]; u32x4 vx[2];
#define P2C_LOAD(item_) do { int b_, h_, n_, row0_, cv_; item_rows((item_), b_, h_, n_, row0_, cv_); \
        _Pragma("unroll") for (int i = 0; i < 16; ++i) { const int t_ = tq * 16 + i; const size_t o_ = (size_t)(row0_ + (t_ < cv_ ? t_ : cv_ - 1)) * 1024 + h_ * 128 + k; lfr[i] = LF[o_]; kr[i] = KK[o_]; qr[i] = QA[o_]; } \
        _Pragma("unroll") for (int r = 0; r < 2; ++r) { const int t_ = (tid + 512 * r) >> 4, v8_ = (tid + 512 * r) & 15; vx[r] = *(const u32x4*)(V + (size_t)(row0_ + (t_ < cv_ ? t_ : cv_ - 1)) * 1024 + h_ * 128 + v8_ * 8); } } while (0)
    if (first < NITEM_P) P2C_LOAD(first);
    for (int item = first; item < NITEM_P; item += step) {
        int b, h, n, row0, cvalid; item_rows(item, b, h, n, row0, cvalid);
        float lf[16], kv[16], qv[16]; float run = 0.f;
#pragma unroll
        for (int i = 0; i < 16; ++i) { const bool ok = tq * 16 + i < cvalid; run += ok ? lfr[i] : 0.f; lf[i] = run; kv[i] = ok ? bf2f(kr[i]) : 0.f; qv[i] = ok ? bf2f(qr[i]) : 0.f; }
        tot[tq * 128 + k] = run;
#pragma unroll
        for (int r = 0; r < 2; ++r) { const int idx = tid + 512 * r, t = idx >> 4, v8 = idx & 15; const u32x4 x = t < cvalid ? vx[r] : (u32x4){0u, 0u, 0u, 0u};
            LAS bf16_t* d = VT + (v8 * 8) * 72 + (((t >> 3) ^ (v8 & 7)) << 3) + (t & 7);
            d[0 * 72] = (bf16_t)(x.x & 0xffff); d[1 * 72] = (bf16_t)(x.x >> 16); d[2 * 72] = (bf16_t)(x.y & 0xffff); d[3 * 72] = (bf16_t)(x.y >> 16);
            d[4 * 72] = (bf16_t)(x.z & 0xffff); d[5 * 72] = (bf16_t)(x.z >> 16); d[6 * 72] = (bf16_t)(x.w & 0xffff); d[7 * 72] = (bf16_t)(x.w >> 16); }
        __syncthreads();
        float off = 0.f;
#pragma unroll
        for (int q = 0; q < 4; ++q) { const float x = tot[q * 128 + k]; if (q < tq) off += x; }
        if (tq == 2) bmid[k] = off + lf[0];
        __syncthreads();
        const float bm = bmid[k];
#pragma unroll
        for (int i = 0; i < 16; ++i) { const int t = tq * 16 + i; const float bt = off + lf[i];
            Qt[t * 136 + k] = (bf16_t)(pk2(qv[i] * fexp(bt - bm), 0.f) & 0xffff);
            Kt[t * 136 + k] = (bf16_t)(pk2(kv[i] * fexp(bm - bt), 0.f) & 0xffff);
            Qd[t * 136 + k] = (bf16_t)(pk2(qv[i] * fexp(bt), 0.f) & 0xffff); }
        bf16x8 stf[4][4]; u32x2 sgv[4]; f32x4 gnv[4];
        { const bf16_t* ST = UB + (size_t)(n > 0 ? item - 1 : item) * 16384; const int tr = tt * 16 + fr, trc = tr < cvalid ? tr : cvalid - 1;
#pragma unroll
          for (int ks = 0; ks < 4; ++ks)
#pragma unroll
              for (int i = 0; i < 4; ++i) stf[ks][i] = *(const bf16x8*)(ST + ((vh * 4 + i) * 16 + fr) * 128 + ks * 32 + fq * 8);
#pragma unroll
          for (int i = 0; i < 4; ++i) { sgv[i] = *(const u32x2*)(SG + (size_t)(row0 + trc) * 1024 + h * 128 + (vh * 4 + i) * 16 + 4 * fq); gnv[i] = *(const f32x4*)(P.in[10] + h * 128 + (vh * 4 + i) * 16 + 4 * fq); } }
        if (item + step < NITEM_P) P2C_LOAD(item + step);
        __syncthreads();
#pragma unroll
        for (int e = 0; e < 2; ++e) { const int st = 2 * vh + e; f32x4 acc = (f32x4){0.f, 0.f, 0.f, 0.f};
            if (st <= tt) {
#pragma unroll
                for (int ks = 0; ks < 4; ++ks) { const bf16x8 X = *(const LAS bf16x8*)(Kt + (st * 16 + fr) * 136 + ks * 32 + fq * 8), Y = *(const LAS bf16x8*)(Qt + (tt * 16 + fr) * 136 + ks * 32 + fq * 8);
                    acc = __builtin_amdgcn_mfma_f32_16x16x32_bf16(X, Y, acc, 0, 0, 0); }
#pragma unroll
                for (int j = 0; j < 4; ++j) if (st * 16 + 4 * fq + j > tt * 16 + fr) acc[j] = 0.f;
            }
            u32x2 o; o.x = pk2(acc[0], acc[1]); o.y = pk2(acc[2], acc[3]);
            *(LAS u32x2*)(Am + (tt * 16 + fr) * 72 + st * 16 + 4 * fq) = o; }
        __syncthreads();
        f32x4 acc[4];
#pragma unroll
        for (int i = 0; i < 4; ++i) acc[i] = (f32x4){0.f, 0.f, 0.f, 0.f};
#pragma unroll
        for (int ks = 0; ks < 2; ++ks) { const bf16x8 Y = *(const LAS bf16x8*)(Am + (tt * 16 + fr) * 72 + ks * 32 + fq * 8);
#pragma unroll
            for (int i = 0; i < 4; ++i) { const int vr = (vh * 4 + i) * 16 + fr; const bf16x8 X = *(const LAS bf16x8*)(VT + vr * 72 + (((ks * 4 + fq) ^ ((vr >> 3) & 7)) << 3)); acc[i] = __builtin_amdgcn_mfma_f32_16x16x32_bf16(X, Y, acc[i], 0, 0, 0); } }
        if (n > 0) {
#pragma unroll
            for (int ks = 0; ks < 4; ++ks) { const bf16x8 Y = *(const LAS bf16x8*)(Qd + (tt * 16 + fr) * 136 + ks * 32 + fq * 8);
#pragma unroll
                for (int i = 0; i < 4; ++i) acc[i] = __builtin_amdgcn_mfma_f32_16x16x32_bf16(stf[ks][i], Y, acc[i], 0, 0, 0); } }
        float ss = 0.f;
#pragma unroll
        for (int i = 0; i < 4; ++i) ss += (acc[i][0] * acc[i][0] + acc[i][1] * acc[i][1]) + (acc[i][2] * acc[i][2] + acc[i][3] * acc[i][3]);
        ss += __shfl_xor(ss, 16); ss += __shfl_xor(ss, 32);
        const int t = tt * 16 + fr;
        if (fq == 0) rmsp[vh * 64 + t] = ss;
        __syncthreads();
        const float scale = 1.0f / sqrtf((rmsp[t] + rmsp[64 + t]) * (1.f / 128.f) + RMS_EPS);
        if (t < cvalid) {
#pragma unroll
            for (int i = 0; i < 4; ++i) { const int v0 = (vh * 4 + i) * 16 + 4 * fq; const f32x4 gn = gnv[i];
                const u32x2 sg = sgv[i];
                u32x2 o; o.x = pk2(acc[i][0] * scale * gn[0] * bflo(sg.x), acc[i][1] * scale * gn[1] * bfhi(sg.x)); o.y = pk2(acc[i][2] * scale * gn[2] * bflo(sg.y), acc[i][3] * scale * gn[3] * bfhi(sg.y));
                *(u32x2*)(A2 + (size_t)(row0 + t) * 2048 + h * 128 + v0) = o; } }
        __syncthreads();
    }
#undef P2C_LOAD
}

__device__ __forceinline__ void skinny_glu(const Params& P, LAS unsigned char* lds, int bslot, int nbslots) {
    const bf16_t* Hs = (const bf16_t*)(P.ws + OFF_H) + (size_t)8704 * D; const bf16_t* W = (const bf16_t*)(P.ws + OFF_WGU); bf16_t* ACT = (bf16_t*)(P.ws + OFF_ACT) + (size_t)8704 * DFF;
    const int tid = threadIdx.x, lane = tid & 63, w = __builtin_amdgcn_readfirstlane(tid >> 6), fr = lane & 15, fq = lane >> 4;
    constexpr int NG = DFF / 16;
    constexpr int RS = 1040;
    const int per_round = nbslots * 8;
    LAS unsigned char* abase = lds + fr * RS + fq * 16;
    int base = 0;
    for (; base + per_round <= NG; base += per_round) {
        const int g = base + bslot * 8 + w;
        const int T = g >> 3, o = (g & 7) * 16;
        const bf16_t* wg = W + (size_t)(T * 256 + o + fr) * D + fq * 8; const bf16_t* wu = wg + (size_t)128 * D;
        f32x4 ag[4], au[4];
#pragma unroll
        for (int m = 0; m < 4; ++m) { ag[m] = (f32x4){0.f, 0.f, 0.f, 0.f}; au[m] = (f32x4){0.f, 0.f, 0.f, 0.f}; }
        bf16x8 xa[16], xb[16];
#define SK_LOAD(dst, bt) do { _Pragma("unroll") for (int i = 0; i < 8; ++i) { dst[i] = *(const bf16x8*)(wg + ((bt) * 8 + i) * 32); dst[8 + i] = *(const bf16x8*)(wu + ((bt) * 8 + i) * 32); } } while (0)
#define SK_MMA(src, half) do { _Pragma("unroll") for (int i = 0; i < 8; ++i) { _Pragma("unroll") for (int m = 0; m < 4; ++m) { \
        const bf16x8 Y = *(const LAS bf16x8*)(abase + m * 16 * RS + ((half) * 8 + i) * 64); \
        ag[m] = __builtin_amdgcn_mfma_f32_16x16x32_bf16(src[i], Y, ag[m], 0, 0, 0); au[m] = __builtin_amdgcn_mfma_f32_16x16x32_bf16(src[8 + i], Y, au[m], 0, 0, 0); } } } while (0)
        SK_LOAD(xa, 0);
#pragma unroll
        for (int ch = 0; ch < 4; ++ch) {
            __syncthreads();
            { u32x4 st[8];
#pragma unroll
              for (int r = 0; r < 8; ++r) { const int idx = tid + 512 * r, row = idx >> 6, c16 = idx & 63; st[r] = *(const u32x4*)(Hs + (size_t)row * D + ch * 512 + c16 * 8); }
#pragma unroll
              for (int r = 0; r < 8; ++r) { const int idx = tid + 512 * r, row = idx >> 6, c16 = idx & 63; *(LAS u32x4*)(lds + row * RS + c16 * 16) = st[r]; } }
            __syncthreads();
            SK_LOAD(xb, 2 * ch + 1); SK_MMA(xa, 0); if (ch < 3) SK_LOAD(xa, 2 * ch + 2); SK_MMA(xb, 1);
        }
#undef SK_LOAD
#undef SK_MMA
#pragma unroll
        for (int m = 0; m < 4; ++m) { const int row = m * 16 + fr; float a[4];
#pragma unroll
            for (int j = 0; j < 4; ++j) a[j] = silu(ag[m][j]) * au[m][j];
            u32x2 o2; o2.x = pk2(a[0], a[1]); o2.y = pk2(a[2], a[3]);
            *(u32x2*)(ACT + (size_t)row * DFF + g * 16 + 4 * fq) = o2; }
    }
    if (bslot < NG - base) {
        const int g = base + bslot;
        const int T = g >> 3, o = (g & 7) * 16;
        const bf16_t* wg = W + (size_t)(T * 256 + o + fr) * D + fq * 8 + w * 256; const bf16_t* wu = wg + (size_t)128 * D;
        const bf16_t* ha = Hs + (size_t)fr * D + fq * 8 + w * 256;
        f32x4 ag[4], au[4];
#pragma unroll
        for (int m = 0; m < 4; ++m) { ag[m] = (f32x4){0.f, 0.f, 0.f, 0.f}; au[m] = (f32x4){0.f, 0.f, 0.f, 0.f}; }
#pragma unroll
        for (int half = 0; half < 2; ++half) { bf16x8 xg[4], xu[4], ya[4][4];
#pragma unroll
            for (int i = 0; i < 4; ++i) { const int kk = (half * 4 + i) * 32; xg[i] = *(const bf16x8*)(wg + kk); xu[i] = *(const bf16x8*)(wu + kk);
#pragma unroll
                for (int m = 0; m < 4; ++m) ya[m][i] = *(const bf16x8*)(ha + (size_t)(m * 16) * D + kk); }
#pragma unroll
            for (int i = 0; i < 4; ++i)
#pragma unroll
                for (int m = 0; m < 4; ++m) { ag[m] = __builtin_amdgcn_mfma_f32_16x16x32_bf16(xg[i], ya[m][i], ag[m], 0, 0, 0); au[m] = __builtin_amdgcn_mfma_f32_16x16x32_bf16(xu[i], ya[m][i], au[m], 0, 0, 0); } }
        __syncthreads();
        LAS f32x4* red = (LAS f32x4*)lds;
#pragma unroll
        for (int m = 0; m < 4; ++m) { red[(w * 8 + m) * 64 + lane] = ag[m]; red[(w * 8 + 4 + m) * 64 + lane] = au[m]; }
        __syncthreads();
        if (w < 4) { const int m = w; f32x4 sg = (f32x4){0.f, 0.f, 0.f, 0.f}, su = (f32x4){0.f, 0.f, 0.f, 0.f};
#pragma unroll
            for (int q = 0; q < 8; ++q) { sg += red[(q * 8 + m) * 64 + lane]; su += red[(q * 8 + 4 + m) * 64 + lane]; }
            const int row = m * 16 + fr; float a[4];
#pragma unroll
            for (int j = 0; j < 4; ++j) a[j] = silu(sg[j]) * su[j];
            u32x2 o2; o2.x = pk2(a[0], a[1]); o2.y = pk2(a[2], a[3]);
            *(u32x2*)(ACT + (size_t)row * DFF + g * 16 + 4 * fq) = o2; }
    }
    __syncthreads();
}

#define XB_TMO      128
#define XB_XCNT(j)  (256  + 64 * (j))
#define XB_XSUB(j)  (1280 + 64 * (j))
#define XB_XGEN(j)  (2304 + 64 * (j))
#define XB_TOP      3328
#define XB_TOPGEN   3392
#define XCD_BAR_WORDS 3456
#define XB_SPIN_CAP (1u << 18)

__device__ __forceinline__ unsigned xb_ld(unsigned* p)              { return __hip_atomic_load(p, __ATOMIC_RELAXED, __HIP_MEMORY_SCOPE_AGENT); }
__device__ __forceinline__ unsigned xb_add(unsigned* p, unsigned v) { return __hip_atomic_fetch_add(p, v, __ATOMIC_RELAXED, __HIP_MEMORY_SCOPE_AGENT); }
__device__ __forceinline__ unsigned xb_xcc_id() { return (unsigned)__builtin_amdgcn_s_getreg((3 << 11) | 20) & 0xFu; }
#define XB_SPIN(cond, bar) do { unsigned _sp = 0; while (cond) { __builtin_amdgcn_s_sleep(1); \
    if ((++_sp & 255u) == 0u) { if (xb_ld(&(bar)[XB_TMO])) break; if (_sp > XB_SPIN_CAP) { atomicAdd(&(bar)[XB_TMO], 1u); break; } } } } while (0)

struct XcdBarrier {
    unsigned* bar; unsigned x;
    volatile LAS unsigned* st;
};

__device__ __forceinline__ XcdBarrier xcd_barrier_post(unsigned* bar, volatile LAS unsigned* st) {
    XcdBarrier b; b.bar = bar; b.x = xb_xcc_id(); b.st = st;
    if (threadIdx.x == 0) (void)xb_add(&bar[XB_XCNT(b.x)], 1u);
    return b;
}
__device__ __forceinline__ void xcd_barrier_complete(unsigned* bar, unsigned x, unsigned& nloc, unsigned& nx) {
    const unsigned G = gridDim.x * gridDim.y * gridDim.z;
    unsigned sum, cnt, mine, sp = 0u;
    for (;;) {
        sum = 0u; cnt = 0u; mine = 0u;
#pragma unroll
        for (unsigned j = 0; j < 16; ++j) { const unsigned c = xb_ld(&bar[XB_XCNT(j)]); sum += c; cnt += (c > 0u) ? 1u : 0u; mine = (j == x) ? c : mine; }
        if (sum == G) break;
        __builtin_amdgcn_s_sleep(1);
        if ((++sp & 255u) == 0u) { if (xb_ld(&bar[XB_TMO])) break; if (sp > XB_SPIN_CAP) { atomicAdd(&bar[XB_TMO], 1u); break; } }
    }
    nloc = mine > 0u ? mine : 1u; nx = cnt > 0u ? cnt : 1u;
}

__device__ __forceinline__ void xcd_barrier(const XcdBarrier& b) {
    asm volatile("s_waitcnt vmcnt(0)" ::: "memory");
    __syncthreads();
    if (threadIdx.x == 0) {
        unsigned* bar = b.bar;
        __builtin_amdgcn_s_waitcnt(0);
        unsigned nloc = b.st[0], nx = b.st[1];
        if (nloc == 0u) { xcd_barrier_complete(bar, b.x, nloc, nx); b.st[0] = nloc; b.st[1] = nx; }
        const unsigned old = xb_add(&bar[XB_XSUB(b.x)], 1u);
        const unsigned gen = old / nloc;
        if (old + 1u == (gen + 1u) * nloc) {
            __builtin_amdgcn_fence(__ATOMIC_RELEASE, "agent");
            asm volatile("s_waitcnt vmcnt(0)" ::: "memory");
            const unsigned og = xb_add(&bar[XB_TOP], 1u);
            const unsigned tg = og / nx;
            if (og + 1u == (tg + 1u) * nx) xb_add(&bar[XB_TOPGEN], 1u);
            else XB_SPIN(xb_ld(&bar[XB_TOPGEN]) == tg, bar);
            __builtin_amdgcn_fence(__ATOMIC_ACQUIRE, "agent");
            xb_add(&bar[XB_XGEN(b.x)], 1u);
            asm volatile("s_waitcnt vmcnt(0)" ::: "memory");
        } else {
            XB_SPIN(xb_ld(&bar[XB_XGEN(b.x)]) == gen, bar);
            __builtin_amdgcn_fence(__ATOMIC_ACQUIRE, "agent");
            asm volatile("s_waitcnt vmcnt(0)" ::: "memory");
        }
    }
    __syncthreads();
}

constexpr int LDS_BYTES = pg8::STAGE_BYTES + 16;
constexpr int NPHASE = 10;

__global__ void __launch_bounds__(512, 2) fwd_kernel(Params P) {
    extern __shared__ __attribute__((aligned(16))) unsigned char shm[];
    LAS unsigned char* lds = (LAS unsigned char*)shm;
    cg::grid_group grid = cg::this_grid();
    unsigned char* ws = P.ws;
    const int lo = P.ph_lo, hi = P.ph_hi, G = gridDim.x, bx = blockIdx.x;
    if (lo < 0) grid.sync();
    volatile LAS unsigned* xb_words = (volatile LAS unsigned*)(lds + pg8::STAGE_BYTES);
    if (threadIdx.x < 4) xb_words[threadIdx.x] = 0u;
    __syncthreads();
    XcdBarrier bar; bar.bar = (unsigned*)(ws + OFF_BAR); bar.x = 0; bar.st = xb_words;
    if (hi - lo > 1) bar = xcd_barrier_post((unsigned*)(ws + OFF_BAR), xb_words);
#define IN(k) (lo <= (k) && (k) < hi)
#define SEAM(k) do { if (IN(k) && IN((k) + 1)) xcd_barrier(bar); } while (0)
    if (IN(0)) phase0(P, lds);
    SEAM(0);
    if (IN(1)) {
        pg8::Gemm g{(const bf16_t*)(ws + OFF_XN), (const bf16_t*)(ws + OFF_WIN), MPAD, NIN, D}; pg8::StaticOrder S; S.init(MPAD, NIN, D, G, bx);
        EpiProj E{(bf16_t*)(ws + OFF_QA), (bf16_t*)(ws + OFF_KK), (bf16_t*)(ws + OFF_V), (bf16_t*)(ws + OFF_SG), (bf16_t*)(ws + OFF_GB), (bf16_t*)(ws + OFF_U), (float*)(ws + OFF_LF), P.in[8], P.in[9]};
        pg8::gemm_phase<EpiProj, pg8::StaticOrder>(lds, g, S, E);
    }
    SEAM(1);
    if (IN(2)) {
        for (int it = bx; it < NITEM_P + NITEM_S; it += G) { if (it < NITEM_P) p2a_item(P, lds, it); else sample_item(P, lds, it - NITEM_P); }
        conv_phase(P);
    }
    SEAM(2);
    if (IN(3)) phase3(P);
    SEAM(3);
    if (IN(4)) { p2c_block(P, lds, bx, G);
        const int nfat = NITEM_P % G;
        if (nfat > 0 && nfat < G) { if (bx >= nfat) cvt_wdown(P, lds, (bx - nfat) * 8 + (int)(threadIdx.x >> 6), (G - nfat) * 8); }
        else cvt_wdown(P, lds, bx * 8 + (int)(threadIdx.x >> 6), G * 8); }
    SEAM(4);
    if (IN(5)) {
        pg8::Gemm g{(const bf16_t*)(ws + OFF_A2), (const bf16_t*)(ws + OFF_WO), MPAD, D, D}; pg8::TailOrder S; S.init(D, G, bx, 4);
        EpiRes E{(bf16_t*)(ws + OFF_T1), (bf16_t*)(ws + OFF_SLAB2)};
        pg8::gemm_phase<EpiRes, pg8::TailOrder>(lds, g, S, E);
    }
    SEAM(5);
    if (IN(6)) { const int lane = threadIdx.x & 63, gw = bx * 8 + (threadIdx.x >> 6), NGW = G * 8;
        for (int r = gw; r < MTOK; r += NGW) {
            if (r < 8192) { f32x4 v[8]; float mean, rstd; ln_row_load_res((const bf16_t*)(ws + OFF_T1) + (size_t)r * TPB, (const bf16_t*)(ws + OFF_XN) + (size_t)r * D, lane, v, mean, rstd);
                ln_store_bf16(v, rstd, P.in[13], P.in[14], (bf16_t*)(ws + OFF_H) + (size_t)r * D, lane); }
            else { f32x4 v[8]; float mean, rstd; ln_row_load_tail<8>((const bf16_t*)(ws + OFF_SLAB2), r - 8192, (const bf16_t*)(ws + OFF_XN) + (size_t)r * D, lane, v, mean, rstd);
                ln_store_bf16(v, rstd, P.in[13], P.in[14], (bf16_t*)(ws + OFF_H) + (size_t)r * D, lane); } } }
    SEAM(6);
    if (IN(7)) {
        constexpr int MMAIN = 8704;
        pg8::Gemm g{(const bf16_t*)(ws + OFF_H), (const bf16_t*)(ws + OFF_WGU), MMAIN, NGU, D}; pg8::StaticOrder S; S.init(MMAIN, NGU, D, G, bx);
        EpiGLU E{(bf16_t*)(ws + OFF_ACT)};
        pg8::gemm_phase<EpiGLU, pg8::StaticOrder>(lds, g, S, E);
        const int nfat = ((MMAIN / 256) * (NGU / 256)) % G;
        if (nfat > 0) { if (bx >= nfat) skinny_glu(P, lds, bx - nfat, G - nfat); } else skinny_glu(P, lds, bx, G);
    }
    SEAM(7);
    if (IN(8)) {
        pg8::Gemm g{(const bf16_t*)(ws + OFF_ACT), (const bf16_t*)(ws + OFF_WIN), MPAD, D, DFF}; pg8::TailOrder S; S.init(DFF, G, bx, 10);
        EpiRes E{(bf16_t*)(ws + OFF_T2), (bf16_t*)(ws + OFF_SLAB4)};
        pg8::gemm_phase<EpiRes, pg8::TailOrder>(lds, g, S, E);
    }
    SEAM(8);
    if (IN(9)) { const int lane = threadIdx.x & 63, gw = bx * 8 + (threadIdx.x >> 6), NGW = G * 8;
        for (int r = gw; r < MTOK; r += NGW) { float* o;
            if (r < MPR) { const int b = r / LP, t = r % LP; if (t < 16) continue; o = P.out + O_YP + ((size_t)b * 2048 + (t - 16)) * D; } else o = P.out + O_YS + (size_t)(r - MPR) * D;
            if (r < 8192) { f32x4 v[8]; float mean, rstd; ln_row_load_res((const bf16_t*)(ws + OFF_T2) + (size_t)r * TPB, (const bf16_t*)(ws + OFF_H) + (size_t)r * D, lane, v, mean, rstd);
                ln_store_f32(v, rstd, P.in[18], P.in[19], o, lane); }
            else { f32x4 v[8]; float mean, rstd; ln_row_load_tail<9>((const bf16_t*)(ws + OFF_SLAB4), r - 8192, (const bf16_t*)(ws + OFF_H) + (size_t)r * D, lane, v, mean, rstd);
                ln_store_f32(v, rstd, P.in[18], P.in[19], o, lane); } } }
#undef IN
#undef SEAM
}

extern "C" void kernel_launch(void* const* d_in, const int* in_sizes, int n_in, void* d_out, int out_size, void* d_ws, size_t ws_size, hipStream_t stream) {
    static int grid = 0;
    if (grid == 0) {
        if (n_in != 20 || ws_size < WS_END) { fprintf(stderr, "kernel_launch: need 20 inputs and %zu bytes of workspace; got %d, %zu\n", (size_t)WS_END, n_in, ws_size); grid = -1; return; }
        int dev = 0, cus = 0, per_cu = 0;
        (void)hipGetDevice(&dev); (void)hipDeviceGetAttribute(&cus, hipDeviceAttributeMultiprocessorCount, dev);
        if (hipFuncSetAttribute((const void*)fwd_kernel, hipFuncAttributeMaxDynamicSharedMemorySize, LDS_BYTES) != hipSuccess) { fprintf(stderr, "kernel_launch: hipFuncSetAttribute failed\n"); grid = -1; return; }
        (void)hipOccupancyMaxActiveBlocksPerMultiprocessor(&per_cu, (const void*)fwd_kernel, 512, LDS_BYTES);
        if (per_cu < 1) per_cu = 1;
        (void)hipGetLastError();
        grid = cus * 1;
    }
    if (grid < 0) return;
    Params p{};
    for (int i = 0; i < 20; ++i) p.in[i] = (const float*)d_in[i];
    p.out = (float*)d_out; p.ws = (unsigned char*)d_ws;
#if N_LAUNCH_MODE == 1
    for (int ph = 0; ph < NPHASE; ++ph) { p.ph_lo = ph; p.ph_hi = ph + 1; hipLaunchKernelGGL(fwd_kernel, dim3(grid), dim3(512), LDS_BYTES, stream, p); }
#else
    p.ph_lo = 0; p.ph_hi = NPHASE;
    (void)hipMemsetAsync((unsigned char*)d_ws + OFF_BAR, 0, 16384, stream);
    void* args[] = {&p};
    hipError_t e = hipLaunchCooperativeKernel((const void*)fwd_kernel, dim3(grid), dim3(512), args, LDS_BYTES, stream);
    if (e != hipSuccess) fprintf(stderr, "cooperative launch failed: %s (grid %d)\n", hipGetErrorString(e), grid);
#endif
}
```

```cpp
#include <hip/hip_runtime.h>
#include <hip/hip_cooperative_groups.h>
#include <cstdio>
namespace cg = cooperative_groups;

#ifndef N_LAUNCH_MODE
#define N_LAUNCH_MODE 0
#endif

#define LAS __attribute__((address_space(3)))
typedef unsigned short bf16_t;
typedef short bf16x8 __attribute__((ext_vector_type(8)));
typedef float f32x4 __attribute__((ext_vector_type(4)));
typedef float f32x2 __attribute__((ext_vector_type(2)));
typedef unsigned u32x4 __attribute__((ext_vector_type(4)));
typedef unsigned u32x2 __attribute__((ext_vector_type(2)));

constexpr int D = 2048, NIN = 7168, DFF = 5632, NGU = 11264;
constexpr int LP = 2064, MPR = 8256, MTOK = 8768, MPAD = 8960;
constexpr int NCH = 33, NITEM_P = 4 * 8 * NCH, NITEM_S = 128 * 8;
constexpr float ALPHA = 1.18920711500272f;
constexpr float LN_EPS = 1e-5f, RMS_EPS = 1e-6f;

constexpr size_t SZ2K = (size_t)MPAD * 2048 * 2, SZ1K = (size_t)MPAD * 1024 * 2;
constexpr size_t OFF_WIN = 0;
constexpr size_t OFF_WO = OFF_WIN + (size_t)NIN * D * 2;
constexpr size_t OFF_WGU = OFF_WO + (size_t)D * D * 2;
constexpr size_t OFF_XN = OFF_WGU + (size_t)NGU * D * 2;
constexpr size_t OFF_A2 = OFF_XN + SZ2K;
constexpr size_t OFF_PROJ = OFF_A2 + SZ2K;
constexpr size_t OFF_QA = OFF_PROJ, OFF_KK = OFF_QA + SZ1K, OFF_V = OFF_KK + SZ1K, OFF_SG = OFF_V + SZ1K, OFF_GB = OFF_SG + SZ1K, OFF_U = OFF_GB + SZ1K, OFF_LF = OFF_U + SZ1K;
constexpr size_t OFF_T1 = OFF_PROJ, OFF_H = OFF_LF, OFF_ACT = OFF_PROJ, OFF_T2 = OFF_XN;
constexpr size_t OFF_UB = OFF_LF + (size_t)MPAD * 1024 * 4;
constexpr size_t OFF_DB = OFF_UB + (size_t)NITEM_P * 16384 * 2;
constexpr size_t OFF_BAR = OFF_DB + (size_t)NITEM_P * 128 * 4;
constexpr size_t WS_END = OFF_BAR + 16384;
static_assert((size_t)MPAD * DFF * 2 <= 6 * SZ1K, "ACT must not reach H");

constexpr int TPB = 2048 + 64;
constexpr int TP = 2048 + 64;
constexpr size_t SLAB_FLOATS = (size_t)(MTOK - 8192) * TP;
constexpr size_t SLAB_ELEMS = (size_t)(MTOK - 8192) * TPB;
constexpr size_t OFF_SLAB2 = OFF_T1 + (size_t)MPAD * 2048 * 4;
constexpr size_t OFF_SLAB4 = OFF_WO;
static_assert(OFF_SLAB2 + 4 * SLAB_FLOATS * 4 <= OFF_H && OFF_SLAB4 + 9 * SLAB_FLOATS * 4 <= OFF_XN && (size_t)8192 * TP * 4 <= 2 * SZ2K, "slabs / T pitch");
constexpr size_t O_YP = 0, O_YS = 16777216, O_HP = O_YS + 1048576, O_CP = O_HP + 524288, O_HS = O_CP + 8192, O_CS = O_HS + 16777216;

struct Params { const float* in[20]; float* out; unsigned char* ws; int ph_lo, ph_hi; };

typedef __bf16 bf2_t __attribute__((ext_vector_type(2)));
__device__ __forceinline__ unsigned pk2(float lo, float hi) { const f32x2 v = {lo, hi}; const bf2_t b = __builtin_convertvector(v, bf2_t); return __builtin_bit_cast(unsigned, b); }
__device__ __forceinline__ float bf2f(bf16_t v) { return __uint_as_float(((unsigned)v) << 16); }
__device__ __forceinline__ float bflo(unsigned w) { return __uint_as_float(w << 16); }
__device__ __forceinline__ float bfhi(unsigned w) { return __uint_as_float(w & 0xffff0000u); }
__device__ __forceinline__ float fexp(float x) { return __expf(x); }
__device__ __forceinline__ float frcp(float x) { return __builtin_amdgcn_rcpf(x); }
__device__ __forceinline__ float silu(float x) { return x * frcp(1.0f + fexp(-x)); }
__device__ __forceinline__ float wave_sum(float v) {
#pragma unroll
    for (int o = 1; o < 64; o <<= 1) v += __shfl_xor(v, o);
    return v;
}
#define LDS_WAIT() asm volatile("s_waitcnt lgkmcnt(0)" ::: "memory")

namespace pg8 {
constexpr int BM = 256, BK = 64, HALF = 128, HTB = HALF * BK * 2, STAGE_BYTES = 8 * HTB, NXCD = 8, WGM = 8;
__host__ __device__ __forceinline__ int lds_byte(int r, int c) { const int st = (r >> 4) * 2 + (c >> 5), rr = r & 15, cc = c & 31, ob = rr * 64 + cc * 2; return st * 1024 + (ob ^ (((ob >> 9) & 1) << 5)); }
__host__ __device__ __forceinline__ void stage_rc(int b, int& R, int& C) { const int st = b / 1024, sb = b % 1024, swz = sb ^ (((sb >> 9) & 1) << 5); R = (st >> 1) * 16 + swz / 64; C = (st & 1) * 32 + (swz % 64) / 2; }
__host__ __device__ __forceinline__ int perm32(int rho) { const int n = rho >> 4, i = rho & 15; return 8 * (i >> 2) + 4 * n + (i & 3); }

struct Unit { int pm, pn, kt0, nt, part; };
struct Gemm { const bf16_t* A; const bf16_t* Bt; int M, N, K; };

struct StaticOrder {
    int nM, nN, nwg, G, c, NT;
    __device__ void init(int M, int N, int K, int G_, int c_) { nM = M / BM; nN = N / BM; nwg = nM * nN; G = G_; c = c_; NT = K / BK; }
    __device__ __forceinline__ bool next(int i, Unit& u) const {
        const long L = (long)i * G + c; if (L >= nwg) return false;
        u.kt0 = 0; u.nt = NT; u.part = -1;
        int wgid = (int)L; { const int q = nwg / NXCD, r = nwg % NXCD, xcd = wgid % NXCD, off = wgid / NXCD; wgid = (xcd < r ? xcd * (q + 1) : r * (q + 1) + (xcd - r) * q) + off; }
        const int nig = WGM * nN, gid = wgid / nig, fm = gid * WGM, gsz = (nM - fm) < WGM ? (nM - fm) : WGM;
        u.pm = fm + ((wgid % nig) % gsz); u.pn = (wgid % nig) / gsz; return true;
    }
};

struct TailOrder {
    StaticOrder so; int PLEN, PPU, NP;
    __device__ void init(int K, int G_, int c_, int plen) { so.init(8192, 2048, K, G_, c_); PLEN = plen; PPU = (so.NT + plen - 1) / plen; NP = 24 * PPU; }
    __device__ __forceinline__ bool next(int i, Unit& u) const {
        Unit f; f.pm = 0; f.pn = 0; f.kt0 = 0; f.nt = so.NT; f.part = -1; const bool isf = so.next(i, f);
        const long p = (long)i * so.G + so.c - so.nwg; const bool isp = !isf && p < NP;
        const int pp = isp ? (int)p : 0, t = pp / PPU, piece = pp - t * PPU, kt0 = piece * PLEN, rem = so.NT - kt0;
        u.pm = isf ? f.pm : 32 + (t >> 3); u.pn = isf ? f.pn : (t & 7); u.kt0 = isf ? 0 : kt0; u.nt = isf ? so.NT : (rem < PLEN ? rem : PLEN); u.part = isf ? -1 : piece;
        return isf || isp;
    }
};

template <class Epi, class Order, bool ALIGN_EPI = true, bool SP2 = true>
__device__ __forceinline__ void gemm_phase(LAS unsigned char* lds, const Gemm g, const Order& S, const Epi& E) {
    const int tid = threadIdx.x, wid = __builtin_amdgcn_readfirstlane(tid >> 6), lane = tid & 63, wr = wid >> 2, wc = wid & 3, fr = lane & 15, fq = lane >> 4;
    const int K = g.K;
    unsigned voffA[2], voffB[2];
#pragma unroll
    for (int i = 0; i < 2; ++i) { int R, C; stage_rc(tid * 16 + i * 8192, R, C); const int Rb = Epi::PERM ? ((R & ~31) + perm32(R & 31)) : R;
        voffA[i] = (unsigned)(R * K + C) * 2u; voffB[i] = (unsigned)(Rb * K + C) * 2u; }
    const size_t kstep = (size_t)(BK * 2);
    const size_t hstep = (size_t)HALF * K * 2;
    const size_t tstep = 2 * hstep;
    const unsigned ldsw = (unsigned)wid * 1024u;
    const int aoff = lds_byte(wr * 64 + fr, fq * 8), boff = lds_byte(wc * 32 + fr, fq * 8);
#define PG8_SA(b, h) (((b) * 2 + (h)) * HTB)
#define PG8_SB(b, h) ((4 + (b) * 2 + (h)) * HTB)
#define PG8_STAGE(bufoff, gbase, voff) do { _Pragma("unroll") for (int _i = 0; _i < 2; ++_i) \
        __builtin_amdgcn_global_load_lds((const unsigned*)((const char*)(gbase) + (voff)[_i]), (LAS unsigned*)(lds + (bufoff) + ldsw + _i * 8192), 16, 0, 0); } while (0)
#define PG8_LDA(dst, b, h) do { _Pragma("unroll") for (int m = 0; m < 4; ++m) _Pragma("unroll") for (int k = 0; k < 2; ++k) dst[m][k] = *(const LAS bf16x8*)(lds + PG8_SA(b, h) + aoff + m * 2048 + k * 1024); } while (0)
#define PG8_LDB(dst, b, h) do { _Pragma("unroll") for (int n = 0; n < 2; ++n) _Pragma("unroll") for (int k = 0; k < 2; ++k) dst[n][k] = *(const LAS bf16x8*)(lds + PG8_SB(b, h) + boff + n * 2048 + k * 1024); } while (0)
#define PG8_MMA(ai, bj, At, Bt) do { __builtin_amdgcn_s_setprio(1); _Pragma("unroll") for (int m = 0; m < 4; ++m) _Pragma("unroll") for (int n = 0; n < 2; ++n) _Pragma("unroll") for (int k = 0; k < 2; ++k) \
        acc[ai][bj][m][n] = __builtin_amdgcn_mfma_f32_16x16x32_bf16(Bt[n][k], At[m][k], acc[ai][bj][m][n], 0, 0, 0); __builtin_amdgcn_s_setprio(0); } while (0)
#define PG8_WAIT_V(n) asm volatile("s_waitcnt vmcnt(" #n ")" ::: "memory")
#define PG8_WAIT_L(n) asm volatile("s_waitcnt lgkmcnt(" #n ")" ::: "memory")
#define PG8_BAR __builtin_amdgcn_s_barrier()
#define PG8_SCHED __builtin_amdgcn_sched_barrier(0)
    Unit cur, nxt; int ui = 0;
    if (!S.next(0, cur)) return;
    f32x4 acc[2][2][4][2];
#pragma unroll
    for (int a = 0; a < 2; ++a)
#pragma unroll
        for (int b = 0; b < 2; ++b)
#pragma unroll
            for (int m = 0; m < 4; ++m)
#pragma unroll
                for (int n = 0; n < 2; ++n) acc[a][b][m][n] = (f32x4){0.f, 0.f, 0.f, 0.f};
    bf16x8 At[4][2], B0[2][2], B1[2][2];
    const char* cA = (const char*)g.A + (size_t)cur.pm * tstep + (size_t)cur.kt0 * kstep; const char* cB = (const char*)g.Bt + (size_t)cur.pn * tstep + (size_t)cur.kt0 * kstep;
    if constexpr (SP2) {
        PG8_STAGE(PG8_SB(0, 0), cB, voffB); PG8_STAGE(PG8_SB(0, 1), cB + hstep, voffB); PG8_STAGE(PG8_SA(0, 0), cA, voffA); PG8_STAGE(PG8_SA(0, 1), cA + hstep, voffA);
        if (wr == 1) PG8_BAR;
        PG8_WAIT_V(2); PG8_BAR;
        PG8_STAGE(PG8_SB(1, 0), cB + kstep, voffB); PG8_STAGE(PG8_SA(1, 0), cA + kstep, voffA); PG8_STAGE(PG8_SB(1, 1), cB + hstep + kstep, voffB);
        PG8_WAIT_V(6); PG8_BAR;
    } else {
    PG8_STAGE(PG8_SB(0, 0), cB, voffB); PG8_STAGE(PG8_SA(0, 0), cA, voffA); PG8_STAGE(PG8_SB(0, 1), cB + hstep, voffB); PG8_STAGE(PG8_SA(0, 1), cA + hstep, voffA);
    if (wr == 1) PG8_BAR;
    PG8_WAIT_V(4); PG8_BAR;
    PG8_STAGE(PG8_SB(1, 0), cB + kstep, voffB); PG8_STAGE(PG8_SA(1, 0), cA + kstep, voffA); PG8_STAGE(PG8_SB(1, 1), cB + hstep + kstep, voffB);
    PG8_WAIT_V(6); PG8_BAR;
    }
    for (;;) {
        const bool has_next = S.next(ui + 1, nxt);
        const char* nA = has_next ? (const char*)g.A + (size_t)nxt.pm * tstep + (size_t)nxt.kt0 * kstep : cA; const char* nB = has_next ? (const char*)g.Bt + (size_t)nxt.pn * tstep + (size_t)nxt.kt0 * kstep : cB;
        const int nt = cur.nt;
        for (int t = 0; t < nt; t += 2) {
            const bool last = (t == nt - 2);
            const char* a1 = cA + (size_t)(t + 1) * kstep;
            const char* a2 = last ? nA : cA + (size_t)(t + 2) * kstep; const char* b2 = last ? nB : cB + (size_t)(t + 2) * kstep;
            const char* a3 = a2 + kstep; const char* b3 = b2 + kstep;
            if constexpr (SP2) {
            PG8_LDB(B0, 0, 0); PG8_LDB(B1, 0, 1); PG8_SCHED; PG8_LDA(At, 0, 0); PG8_STAGE(PG8_SA(1, 1), a1 + hstep, voffA);
            PG8_WAIT_V(8); PG8_WAIT_L(0); PG8_BAR; PG8_MMA(0, 0, At, B0); PG8_MMA(0, 1, At, B1); PG8_BAR; PG8_SCHED;
            PG8_LDA(At, 0, 1); PG8_STAGE(PG8_SB(0, 0), b2, voffB); PG8_STAGE(PG8_SB(0, 1), b2 + hstep, voffB); PG8_STAGE(PG8_SA(0, 0), a2, voffA);
            PG8_WAIT_V(8); PG8_WAIT_L(0); PG8_BAR; PG8_MMA(1, 0, At, B0); PG8_MMA(1, 1, At, B1); PG8_BAR; PG8_SCHED;
            PG8_LDB(B0, 1, 0); PG8_LDB(B1, 1, 1); PG8_SCHED; PG8_LDA(At, 1, 0); PG8_STAGE(PG8_SA(0, 1), a2 + hstep, voffA);
            PG8_WAIT_V(8); PG8_WAIT_L(0); PG8_BAR; PG8_MMA(0, 0, At, B0); PG8_MMA(0, 1, At, B1); PG8_BAR; PG8_SCHED;
            PG8_LDA(At, 1, 1); PG8_STAGE(PG8_SB(1, 0), b3, voffB); PG8_STAGE(PG8_SB(1, 1), b3 + hstep, voffB); PG8_STAGE(PG8_SA(1, 0), a3, voffA);
            PG8_WAIT_V(8); PG8_WAIT_L(0); PG8_BAR; PG8_MMA(1, 0, At, B0); PG8_MMA(1, 1, At, B1); PG8_BAR; PG8_SCHED;
            } else {
            PG8_LDB(B0, 0, 0); PG8_SCHED; PG8_LDA(At, 0, 0); PG8_STAGE(PG8_SA(1, 1), a1 + hstep, voffA);
            PG8_WAIT_L(8); PG8_BAR; PG8_WAIT_L(0); PG8_MMA(0, 0, At, B0); PG8_BAR; PG8_SCHED;
            PG8_LDB(B1, 0, 1); PG8_STAGE(PG8_SB(0, 0), b2, voffB);
            PG8_BAR; PG8_WAIT_L(0); PG8_MMA(0, 1, At, B1); PG8_BAR;
            PG8_LDA(At, 0, 1); PG8_STAGE(PG8_SA(0, 0), a2, voffA);
            PG8_BAR; PG8_WAIT_L(0); PG8_MMA(1, 0, At, B0); PG8_BAR; PG8_SCHED;
            PG8_STAGE(PG8_SB(0, 1), b2 + hstep, voffB);
            PG8_WAIT_V(6); PG8_BAR; PG8_MMA(1, 1, At, B1); PG8_BAR;
            PG8_LDB(B0, 1, 0); PG8_SCHED; PG8_LDA(At, 1, 0); PG8_STAGE(PG8_SA(0, 1), a2 + hstep, voffA);
            PG8_WAIT_L(8); PG8_BAR; PG8_WAIT_L(0); PG8_MMA(0, 0, At, B0); PG8_BAR; PG8_SCHED;
            PG8_LDB(B1, 1, 1); PG8_STAGE(PG8_SB(1, 0), b3, voffB);
            PG8_BAR; PG8_WAIT_L(0); PG8_MMA(0, 1, At, B1); PG8_BAR;
            PG8_LDA(At, 1, 1); PG8_STAGE(PG8_SA(1, 0), a3, voffA);
            PG8_BAR; PG8_WAIT_L(0); PG8_MMA(1, 0, At, B0); PG8_BAR; PG8_SCHED;
            PG8_STAGE(PG8_SB(1, 1), b3 + hstep, voffB);
            PG8_WAIT_V(6); PG8_BAR; PG8_MMA(1, 1, At, B1); PG8_BAR;
            }
        }
        if constexpr (ALIGN_EPI) { if (wr == 0) PG8_BAR; }
        E(acc, cur, wr, wc, fr, fq);
        if (!has_next) break;
#pragma unroll
        for (int a = 0; a < 2; ++a)
#pragma unroll
            for (int b = 0; b < 2; ++b)
#pragma unroll
                for (int m = 0; m < 4; ++m)
#pragma unroll
                    for (int n = 0; n < 2; ++n) acc[a][b][m][n] = (f32x4){0.f, 0.f, 0.f, 0.f};
        cur = nxt; cA = nA; cB = nB; ++ui;
        if constexpr (ALIGN_EPI) { if (wr == 1) PG8_BAR; }
    }
    PG8_WAIT_V(0);
    if constexpr (!ALIGN_EPI) { if (wr == 0) PG8_BAR; }
    PG8_BAR;
#undef PG8_SA
#undef PG8_SB
#undef PG8_STAGE
#undef PG8_LDA
#undef PG8_LDB
#undef PG8_MMA
#undef PG8_WAIT_V
#undef PG8_WAIT_L
#undef PG8_BAR
#undef PG8_SCHED
}
}

struct EpiProj {
    static constexpr bool PERM = true;
    bf16_t *QA, *KK, *V, *SG, *GB, *U; float* LF; const float* b_f; const float* lbp;
    __device__ __forceinline__ void operator()(const f32x4 (&acc)[2][2][4][2], const pg8::Unit& u, int wr, int wc, int fr, int fq) const {
        const int row0 = u.pm * 256 + wr * 64 + fr;
        if (u.pn >= 20) {
            const int c0 = (u.pn - 20) * 128 + wc * 32 + 8 * fq;
#pragma unroll
            for (int ai = 0; ai < 2; ++ai)
#pragma unroll
                for (int m = 0; m < 4; ++m) { const size_t row = row0 + ai * 128 + m * 16;
                    const f32x4 a = acc[ai][0][m][0] * acc[ai][1][m][0], b = acc[ai][0][m][1] * acc[ai][1][m][1];
                    u32x4 w; w.x = pk2(a[0], a[1]); w.y = pk2(a[2], a[3]); w.z = pk2(b[0], b[1]); w.w = pk2(b[2], b[3]);
                    *(u32x4*)(U + row * 1024 + c0) = w; }
            return;
        }
        const int seg = u.pn >> 2;
        if (seg == 1) {
#pragma unroll
            for (int bj = 0; bj < 2; ++bj) { const int c0 = (u.pn - 4) * 256 + bj * 128 + wc * 32 + 8 * fq;
                float bf[8], oml[8];
#pragma unroll
                for (int j = 0; j < 8; ++j) { bf[j] = b_f[c0 + j]; const float lb = frcp(1.0f + fexp(lbp[1024 + c0 + j] - lbp[c0 + j])); oml[j] = 1.0f - lb; }
#pragma unroll
                for (int ai = 0; ai < 2; ++ai)
#pragma unroll
                    for (int m = 0; m < 4; ++m) { const size_t row = row0 + ai * 128 + m * 16; float kk[8], lf[8];
#pragma unroll
                        for (int n = 0; n < 2; ++n)
#pragma unroll
                            for (int j = 0; j < 4; ++j) { const float z = acc[ai][bj][m][n][j] + bf[4 * n + j]; const float k = oml[4 * n + j] * frcp(1.0f + fexp(z)); kk[4 * n + j] = k; lf[4 * n + j] = __logf(1.0f - k); }
                        u32x4 w; w.x = pk2(kk[0], kk[1]); w.y = pk2(kk[2], kk[3]); w.z = pk2(kk[4], kk[5]); w.w = pk2(kk[6], kk[7]);
                        *(u32x4*)(KK + row * 1024 + c0) = w;
                        *(f32x4*)(LF + row * 1024 + c0) = (f32x4){lf[0], lf[1], lf[2], lf[3]}; *(f32x4*)(LF + row * 1024 + c0 + 4) = (f32x4){lf[4], lf[5], lf[6], lf[7]}; }
            }
            return;
        }
        bf16_t* dst = seg == 0 ? QA : (seg == 2 ? V : (seg == 3 ? SG : GB));
        const bool act = (seg == 0 || seg == 3);
#pragma unroll
        for (int bj = 0; bj < 2; ++bj) { const int c0 = (u.pn & 3) * 256 + bj * 128 + wc * 32 + 8 * fq;
#pragma unroll
            for (int ai = 0; ai < 2; ++ai)
#pragma unroll
                for (int m = 0; m < 4; ++m) { const size_t row = row0 + ai * 128 + m * 16; f32x4 a = acc[ai][bj][m][0], b = acc[ai][bj][m][1];
                    if (act) {
#pragma unroll
                        for (int j = 0; j < 4; ++j) { a[j] = silu(a[j]); b[j] = silu(b[j]); } }
                    u32x4 w; w.x = pk2(a[0], a[1]); w.y = pk2(a[2], a[3]); w.z = pk2(b[0], b[1]); w.w = pk2(b[2], b[3]);
                    *(u32x4*)(dst + row * 1024 + c0) = w; }
        }
    }
};
struct EpiRes {
    static constexpr bool PERM = true;
    bf16_t* T; bf16_t* slab;
    __device__ __forceinline__ void operator()(const f32x4 (&acc)[2][2][4][2], const pg8::Unit& u, int wr, int wc, int fr, int fq) const {
        const int row0 = u.pm * 256 + wr * 64 + fr, col0 = u.pn * 256 + wc * 32 + 8 * fq;
        if (u.part >= 0) {
            bf16_t* S = slab + (size_t)u.part * SLAB_ELEMS;
#pragma unroll
            for (int ai = 0; ai < 2; ++ai)
#pragma unroll
                for (int m = 0; m < 4; ++m) { const int row = row0 + ai * 128 + m * 16; if (row < MTOK) { bf16_t* p = S + (size_t)(row - 8192) * TPB + col0;
#pragma unroll
                    for (int bj = 0; bj < 2; ++bj) { const f32x4 a = acc[ai][bj][m][0], b = acc[ai][bj][m][1];
                        u32x4 w; w.x = pk2(a[0], a[1]); w.y = pk2(a[2], a[3]); w.z = pk2(b[0], b[1]); w.w = pk2(b[2], b[3]);
                        *(u32x4*)(p + bj * 128) = w; } } }
            return;
        }
#pragma unroll
        for (int ai = 0; ai < 2; ++ai)
#pragma unroll
            for (int m = 0; m < 4; ++m) { bf16_t* p = T + (size_t)(row0 + ai * 128 + m * 16) * TPB + col0;
#pragma unroll
                for (int bj = 0; bj < 2; ++bj) { const f32x4 a = acc[ai][bj][m][0], b = acc[ai][bj][m][1];
                    u32x4 w; w.x = pk2(a[0], a[1]); w.y = pk2(a[2], a[3]); w.z = pk2(b[0], b[1]); w.w = pk2(b[2], b[3]);
                    *(u32x4*)(p + bj * 128) = w; } }
    }
};
struct EpiGLU {
    static constexpr bool PERM = true;
    bf16_t* ACT;
    __device__ __forceinline__ void operator()(const f32x4 (&acc)[2][2][4][2], const pg8::Unit& u, int wr, int wc, int fr, int fq) const {
        const int row0 = u.pm * 256 + wr * 64 + fr, c0 = u.pn * 128 + wc * 32 + 8 * fq;
#pragma unroll
        for (int ai = 0; ai < 2; ++ai)
#pragma unroll
            for (int m = 0; m < 4; ++m) { const size_t row = row0 + ai * 128 + m * 16; f32x4 a, b;
#pragma unroll
                for (int j = 0; j < 4; ++j) { a[j] = silu(acc[ai][0][m][0][j]) * acc[ai][1][m][0][j]; b[j] = silu(acc[ai][0][m][1][j]) * acc[ai][1][m][1][j]; }
                u32x4 w; w.x = pk2(a[0], a[1]); w.y = pk2(a[2], a[3]); w.z = pk2(b[0], b[1]); w.w = pk2(b[2], b[3]);
                *(u32x4*)(ACT + row * DFF + c0) = w; }
    }
};

__device__ __forceinline__ void cvt_item(const float* W, int N, bf16_t* WT, int K, int dst_row0, int k0, int n0, LAS float* scr, int lane) {
#pragma unroll 8
    for (int i = 0; i < 32; ++i) { const int kk = 2 * i + (lane >> 5); scr[kk * 33 + (lane & 31)] = W[(size_t)(k0 + kk) * N + n0 + (lane & 31)]; }
    LDS_WAIT();
    const int c = lane & 7;
#pragma unroll
    for (int j = 0; j < 4; ++j) { const int n = (lane >> 3) + 8 * j; const LAS float* s = scr + (8 * c) * 33 + n;
        u32x4 o; o.x = pk2(s[0 * 33], s[1 * 33]); o.y = pk2(s[2 * 33], s[3 * 33]); o.z = pk2(s[4 * 33], s[5 * 33]); o.w = pk2(s[6 * 33], s[7 * 33]);
        *(u32x4*)(WT + (size_t)(dst_row0 + n) * K + k0 + 8 * c) = o; }
    LDS_WAIT();
}
__device__ __forceinline__ int map_win(int n0) { if (n0 < 5120) return n0; const int j = n0 - 5120, which = j >> 10, jj = j & 1023; return 5120 + (jj >> 7) * 256 + which * 128 + (jj & 127); }
__device__ __forceinline__ int map_gu(int n0, int which) { return (n0 >> 7) * 256 + which * 128 + (n0 & 127); }

__device__ __forceinline__ void ln_row_load(const float* xrow, int lane, f32x4 (&v)[8], float& mean, float& rstd) {
    const f32x4* xr = (const f32x4*)xrow + lane; float s = 0.f;
#pragma unroll
    for (int j = 0; j < 8; ++j) { v[j] = xr[64 * j]; s += (v[j][0] + v[j][1]) + (v[j][2] + v[j][3]); }
    mean = wave_sum(s) * (1.f / 2048.f); float s2 = 0.f;
#pragma unroll
    for (int j = 0; j < 8; ++j) { v[j] = v[j] - mean; s2 += (v[j][0] * v[j][0] + v[j][1] * v[j][1]) + (v[j][2] * v[j][2] + v[j][3] * v[j][3]); }
    rstd = 1.0f / sqrtf(wave_sum(s2) * (1.f / 2048.f) + LN_EPS);
}
__device__ __forceinline__ void ln_stats(int lane, f32x4 (&v)[8], float& mean, float& rstd) {
    float s = 0.f;
#pragma unroll
    for (int j = 0; j < 8; ++j) s += (v[j][0] + v[j][1]) + (v[j][2] + v[j][3]);
    mean = wave_sum(s) * (1.f / 2048.f); float s2 = 0.f;
#pragma unroll
    for (int j = 0; j < 8; ++j) { v[j] = v[j] - mean; s2 += (v[j][0] * v[j][0] + v[j][1] * v[j][1]) + (v[j][2] * v[j][2] + v[j][3] * v[j][3]); }
    rstd = 1.0f / sqrtf(wave_sum(s2) * (1.f / 2048.f) + LN_EPS);
}
__device__ __forceinline__ void ln_row_load_res(const bf16_t* trow, const bf16_t* resrow, int lane, f32x4 (&v)[8], float& mean, float& rstd) {
#pragma unroll
    for (int j = 0; j < 8; ++j) { const u32x2 r = ((const u32x2*)resrow)[lane + 64 * j]; const u32x2 t = ((const u32x2*)trow)[lane + 64 * j];
        v[j] = (f32x4){ALPHA * bflo(r.x) + bflo(t.x), ALPHA * bfhi(r.x) + bfhi(t.x), ALPHA * bflo(r.y) + bflo(t.y), ALPHA * bfhi(r.y) + bfhi(t.y)}; }
    ln_stats(lane, v, mean, rstd);
}
template <int NPARTS> __device__ __forceinline__ void ln_row_load_tail(const bf16_t* slab, int rowt, const bf16_t* resrow, int lane, f32x4 (&v)[8], float& mean, float& rstd) {
#pragma unroll
    for (int j = 0; j < 8; ++j) { const u32x2 r = ((const u32x2*)resrow)[lane + 64 * j]; v[j] = (f32x4){ALPHA * bflo(r.x), ALPHA * bfhi(r.x), ALPHA * bflo(r.y), ALPHA * bfhi(r.y)}; }
#pragma unroll
    for (int p = 0; p < NPARTS; ++p) { const u32x2* sp = (const u32x2*)(slab + (size_t)p * SLAB_ELEMS + (size_t)rowt * TPB) + lane;
#pragma unroll
        for (int j = 0; j < 8; ++j) { const u32x2 t = sp[64 * j]; v[j] += (f32x4){bflo(t.x), bfhi(t.x), bflo(t.y), bfhi(t.y)}; } }
    ln_stats(lane, v, mean, rstd);
}
__device__ __forceinline__ void ln_store_bf16(const f32x4 (&v)[8], float rstd, const float* g, const float* b, bf16_t* orow, int lane) {
    u32x2* o8 = (u32x2*)orow + lane;
#pragma unroll
    for (int j = 0; j < 8; ++j) { const f32x4 gg = ((const f32x4*)g)[lane + 64 * j], bb = ((const f32x4*)b)[lane + 64 * j]; const f32x4 y = v[j] * rstd * gg + bb;
        u32x2 w; w.x = pk2(y[0], y[1]); w.y = pk2(y[2], y[3]); o8[64 * j] = w; }
}
__device__ __forceinline__ void ln_store_f32(const f32x4 (&v)[8], float rstd, const float* g, const float* b, float* orow, int lane) {
    f32x4* o = (f32x4*)orow + lane;
#pragma unroll
    for (int j = 0; j < 8; ++j) { const f32x4 gg = ((const f32x4*)g)[lane + 64 * j], bb = ((const f32x4*)b)[lane + 64 * j]; o[64 * j] = v[j] * rstd * gg + bb; }
}
__device__ __forceinline__ void ln_row_bf16(const float* xrow, const float* g, const float* b, bf16_t* orow, int lane) {
    f32x4 v[8]; float mean, rstd; ln_row_load(xrow, lane, v, mean, rstd);
    u32x2* o8 = (u32x2*)orow + lane;
#pragma unroll
    for (int j = 0; j < 8; ++j) { const f32x4 gg = ((const f32x4*)g)[lane + 64 * j], bb = ((const f32x4*)b)[lane + 64 * j]; const f32x4 y = v[j] * rstd * gg + bb;
        u32x2 w; w.x = pk2(y[0], y[1]); w.y = pk2(y[2], y[3]); o8[64 * j] = w; }
}
__device__ __forceinline__ void ln_row_f32(const float* xrow, const float* g, const float* b, float* orow, int lane) {
    f32x4 v[8]; float mean, rstd; ln_row_load(xrow, lane, v, mean, rstd);
    f32x4* o = (f32x4*)orow + lane;
#pragma unroll
    for (int j = 0; j < 8; ++j) { const f32x4 gg = ((const f32x4*)g)[lane + 64 * j], bb = ((const f32x4*)b)[lane + 64 * j]; o[64 * j] = v[j] * rstd * gg + bb; }
}

__device__ __forceinline__ void phase0(const Params& P, LAS unsigned char* lds) {
    const int tid = threadIdx.x, lane = tid & 63, wave = tid >> 6, gw = blockIdx.x * 8 + wave, NGW = gridDim.x * 8;
    LAS float* scr = (LAS float*)(lds + wave * 8704);
    unsigned char* ws = P.ws;
    constexpr int I_IN = 32 * 224, I_O = 32 * 64, I_G = 32 * 176;
    for (int it = gw; it < I_IN + I_O + 2 * I_G; it += NGW) {
        int r = it;
        if (r < I_IN) { const int kb = r / 224, nb = r % 224; cvt_item(P.in[7], NIN, (bf16_t*)(ws + OFF_WIN), D, map_win(nb * 32), kb * 64, nb * 32, scr, lane); continue; } r -= I_IN;
        if (r < I_O) { const int kb = r / 64, nb = r % 64; cvt_item(P.in[12], D, (bf16_t*)(ws + OFF_WO), D, nb * 32, kb * 64, nb * 32, scr, lane); continue; } r -= I_O;
        if (r < I_G) { const int kb = r / 176, nb = r % 176; cvt_item(P.in[15], DFF, (bf16_t*)(ws + OFF_WGU), D, map_gu(nb * 32, 0), kb * 64, nb * 32, scr, lane); continue; } r -= I_G;
        { const int kb = r / 176, nb = r % 176; cvt_item(P.in[16], DFF, (bf16_t*)(ws + OFF_WGU), D, map_gu(nb * 32, 1), kb * 64, nb * 32, scr, lane); }
    }
    bf16_t* XN = (bf16_t*)(ws + OFF_XN);
    for (int r = gw; r < MPAD; r += NGW) {
        if (r >= MTOK) { u32x2* o8 = (u32x2*)(XN + (size_t)r * D) + lane;
#pragma unroll
            for (int j = 0; j < 8; ++j) o8[64 * j] = (u32x2){0u, 0u};
            continue; }
        const float* src;
        if (r < MPR) { const int b = r / LP, t = r % LP; src = t < 16 ? P.in[4] + (size_t)t * D : P.in[0] + ((size_t)b * 2048 + (t - 16)) * D; }
        else src = P.in[1] + (size_t)(r - MPR) * D;
        ln_row_bf16(src, P.in[5], P.in[6], XN + (size_t)r * D, lane);
    }
}

__device__ __forceinline__ void item_rows(int item, int& b, int& h, int& n, int& row0, int& cvalid) {
    b = item / (8 * NCH); const int rem = item % (8 * NCH); h = rem / NCH; n = rem % NCH;
    row0 = b * LP + (n == 0 ? 0 : 16 + (n - 1) * 64); cvalid = n == 0 ? 16 : 64;
}
__device__ __forceinline__ void p2a_item(const Params& P, LAS unsigned char* lds, int item) {
    unsigned char* ws = P.ws;
    const float* LF = (const float*)(ws + OFF_LF); const bf16_t* KK = (const bf16_t*)(ws + OFF_KK); const bf16_t* V = (const bf16_t*)(ws + OFF_V);
    bf16_t* UB = (bf16_t*)(ws + OFF_UB); float* DB = (float*)(ws + OFF_DB);
    int b, h, n, row0, cvalid; item_rows(item, b, h, n, row0, cvalid);
    LAS bf16_t* KdT = (LAS bf16_t*)lds; LAS bf16_t* VT = (LAS bf16_t*)(lds + 18432); LAS float* tot = (LAS float*)(lds + 36864);
    const int tid = threadIdx.x, k = tid & 127, tq = tid >> 7, lane = tid & 63, w = tid >> 6, fr = lane & 15, fq = lane >> 4;
    float lf[16], kv[16]; float run = 0.f;
#pragma unroll
    for (int i = 0; i < 16; ++i) { const int t = tq * 16 + i; const bool ok = t < cvalid; const size_t o = (size_t)(row0 + (ok ? t : cvalid - 1)) * 1024 + h * 128 + k;
        lf[i] = LF[o]; kv[i] = bf2f(KK[o]); if (!ok) { lf[i] = 0.f; kv[i] = 0.f; } }
    u32x4 vx[2];
#pragma unroll
    for (int r = 0; r < 2; ++r) { const int idx = tid + 512 * r, t = idx >> 4, v8 = idx & 15; const bool ok = t < cvalid;
        vx[r] = *(const u32x4*)(V + (size_t)(row0 + (ok ? t : cvalid - 1)) * 1024 + h * 128 + v8 * 8); if (!ok) vx[r] = (u32x4){0u, 0u, 0u, 0u}; }
#pragma unroll
    for (int i = 0; i < 16; ++i) { run += lf[i]; lf[i] = run; }
    tot[tq * 128 + k] = run;
#pragma unroll
    for (int r = 0; r < 2; ++r) { const int idx = tid + 512 * r, t = idx >> 4, v8 = idx & 15; const u32x4 x = vx[r];
        LAS bf16_t* d = VT + (v8 * 8) * 72 + (((t >> 3) ^ (v8 & 7)) << 3) + (t & 7);
        d[0 * 72] = (bf16_t)(x.x & 0xffff); d[1 * 72] = (bf16_t)(x.x >> 16); d[2 * 72] = (bf16_t)(x.y & 0xffff); d[3 * 72] = (bf16_t)(x.y >> 16);
        d[4 * 72] = (bf16_t)(x.z & 0xffff); d[5 * 72] = (bf16_t)(x.z >> 16); d[6 * 72] = (bf16_t)(x.w & 0xffff); d[7 * 72] = (bf16_t)(x.w >> 16); }
    __syncthreads();
    float off = 0.f, blast = 0.f;
#pragma unroll
    for (int q = 0; q < 4; ++q) { const float x = tot[q * 128 + k]; blast += x; if (q < tq) off += x; }
    { unsigned pw[8];
#pragma unroll
      for (int i = 0; i < 8; ++i) { const float k0 = kv[2 * i] * fexp(blast - (off + lf[2 * i])), k1 = kv[2 * i + 1] * fexp(blast - (off + lf[2 * i + 1])); pw[i] = pk2(k0, k1); }
      LAS u32x4* d = (LAS u32x4*)(KdT + k * 72 + tq * 16); d[0] = (u32x4){pw[0], pw[1], pw[2], pw[3]}; d[1] = (u32x4){pw[4], pw[5], pw[6], pw[7]}; }
    if (tq == 0) DB[(size_t)item * 128 + k] = fexp(blast);
    __syncthreads();
    {
        bf16x8 X[2];
#pragma unroll
        for (int ks = 0; ks < 2; ++ks) X[ks] = *(const LAS bf16x8*)(KdT + (w * 16 + fr) * 72 + ks * 32 + fq * 8);
        bf16_t* ub = UB + (size_t)item * 16384;
#pragma unroll
        for (int vt = 0; vt < 8; ++vt) { f32x4 acc = (f32x4){0.f, 0.f, 0.f, 0.f};
#pragma unroll
            for (int ks = 0; ks < 2; ++ks) { const int vr = vt * 16 + fr; const bf16x8 Y = *(const LAS bf16x8*)(VT + vr * 72 + (((ks * 4 + fq) ^ ((vr >> 3) & 7)) << 3)); acc = __builtin_amdgcn_mfma_f32_16x16x32_bf16(X[ks], Y, acc, 0, 0, 0); }
            u32x2 o; o.x = pk2(acc[0], acc[1]); o.y = pk2(acc[2], acc[3]);
            *(u32x2*)(ub + (vt * 16 + fr) * 128 + w * 16 + 4 * fq) = o; }
    }
    __syncthreads();
}
__device__ __forceinline__ void sample_item(const Params& P, LAS unsigned char* lds, int item) {
    unsigned char* ws = P.ws;
    const float* LF = (const float*)(ws + OFF_LF); const bf16_t* KK = (const bf16_t*)(ws + OFF_KK); const bf16_t* V = (const bf16_t*)(ws + OFF_V);
    const bf16_t* QA = (const bf16_t*)(ws + OFF_QA); const bf16_t* SG = (const bf16_t*)(ws + OFF_SG); bf16_t* A2 = (bf16_t*)(ws + OFF_A2);
    const int b = item >> 3, h = item & 7, r0 = MPR + b * 4, col = h * 128;
    LAS float* s_qd = (LAS float*)lds; LAS float* s_kd = s_qd + 512; LAS float* s_dec = s_kd + 512; LAS float* s_v = s_dec + 128; LAS float* s_ap = s_v + 512; LAS float* s_rms = s_ap + 32; LAS float* s_red = s_rms + 32;
    const int tid = threadIdx.x, lane = tid & 63, wave = tid >> 6;
    if (tid < 128) { const int k = tid; float bt[4], q[4], kk[4]; float run = 0.f;
#pragma unroll
        for (int t = 0; t < 4; ++t) { const size_t o = (size_t)(r0 + t) * 1024 + col + k; run += LF[o]; bt[t] = run; q[t] = bf2f(QA[o]); kk[t] = bf2f(KK[o]); }
#pragma unroll
        for (int t = 0; t < 4; ++t) { s_qd[t * 128 + k] = q[t] * fexp(bt[t]); s_kd[t * 128 + k] = kk[t] * fexp(bt[3] - bt[t]); }
        s_dec[k] = fexp(bt[3]);
#pragma unroll
        for (int t = 0; t < 4; ++t)
#pragma unroll
            for (int s = 0; s < 4; ++s) if (s <= t) { const float a = wave_sum(q[t] * kk[s] * fexp(bt[t] - bt[s])); if (lane == 0) s_ap[wave * 16 + t * 4 + s] = a; }
    } else if (tid < 256) { const int v = tid - 128;
#pragma unroll
        for (int t = 0; t < 4; ++t) s_v[t * 128 + v] = bf2f(V[(size_t)(r0 + t) * 1024 + col + v]); }
    __syncthreads();
    const float gn_pre = P.in[10][col + (tid & 127)], sg_pre = bf2f(SG[(size_t)(r0 + (tid >> 7)) * 1024 + col + (tid & 127)]);
    const int v4 = tid & 31, kg = tid >> 5;
    const float* S0p = P.in[2] + ((size_t)(b * 8 + h) * 128) * 128 + v4 * 4; float* Snp = P.out + O_HS + ((size_t)(b * 8 + h) * 128) * 128 + v4 * 4;
    f32x4 s0[8];
#pragma unroll
    for (int j = 0; j < 8; ++j) s0[j] = *(const f32x4*)(S0p + (size_t)(kg + 16 * j) * 128);
    f32x4 vv[4], o[4];
#pragma unroll
    for (int t = 0; t < 4; ++t) { vv[t] = *(const LAS f32x4*)(s_v + t * 128 + v4 * 4); o[t] = (f32x4){0.f, 0.f, 0.f, 0.f}; }
#pragma unroll
    for (int j = 0; j < 8; ++j) { const int k = kg + 16 * j; f32x4 sn = s0[j] * s_dec[k];
#pragma unroll
        for (int t = 0; t < 4; ++t) { sn += vv[t] * s_kd[t * 128 + k]; o[t] += s0[j] * s_qd[t * 128 + k]; }
        *(f32x4*)(Snp + (size_t)k * 128) = sn; }
#pragma unroll
    for (int t = 0; t < 4; ++t) *(LAS f32x4*)(s_red + (kg * 4 + t) * 128 + v4 * 4) = o[t];
    __syncthreads();
    { const int t = tid >> 7, v = tid & 127; float ov = 0.f;
#pragma unroll
      for (int g = 0; g < 16; ++g) ov += s_red[(g * 4 + t) * 128 + v];
#pragma unroll
      for (int s = 0; s < 4; ++s) if (s <= t) ov += (s_ap[t * 4 + s] + s_ap[16 + t * 4 + s]) * s_v[s * 128 + v];
      const float ss = wave_sum(ov * ov); if (lane == 0) s_rms[wave] = ss;
      __syncthreads();
      const float scale = 1.0f / sqrtf((s_rms[2 * t] + s_rms[2 * t + 1]) * (1.f / 128.f) + RMS_EPS);
      const float y = ov * scale * gn_pre * sg_pre;
      A2[(size_t)(r0 + t) * 2048 + col + v] = (bf16_t)(pk2(y, 0.f) & 0xffff); }
    __syncthreads();
}
__device__ __forceinline__ void unpack8(const u32x4 x, float (&f)[8]) { f[0] = bflo(x.x); f[1] = bfhi(x.x); f[2] = bflo(x.y); f[3] = bfhi(x.y); f[4] = bflo(x.z); f[5] = bfhi(x.z); f[6] = bflo(x.w); f[7] = bfhi(x.w); }
__device__ __forceinline__ void conv_phase(const Params& P) {
    unsigned char* ws = P.ws;
    const bf16_t* U = (const bf16_t*)(ws + OFF_U); const bf16_t* GB = (const bf16_t*)(ws + OFF_GB); bf16_t* A2 = (bf16_t*)(ws + OFF_A2);
    const float* cw = P.in[11]; const float* sc = P.in[3];
    const int gt = blockIdx.x * 512 + threadIdx.x, NT = gridDim.x * 512;
    for (int idx = gt; idx < MTOK * 128; idx += NT) {
        const int r = idx >> 7, c8 = (idx & 127) * 8;
        int t, L, bs; const bool samp = r >= MPR;
        if (!samp) { bs = r / LP; t = r - bs * LP; L = LP; } else { bs = (r - MPR) >> 2; t = (r - MPR) & 3; L = 4; }
        const u32x4 x2 = *(const u32x4*)(U + (size_t)r * 1024 + c8), xg = *(const u32x4*)(GB + (size_t)r * 1024 + c8);
        const u32x4 x1 = *(const u32x4*)(U + (size_t)(r >= 1 ? r - 1 : 0) * 1024 + c8), x0 = *(const u32x4*)(U + (size_t)(r >= 2 ? r - 2 : 0) * 1024 + c8);
        const f32x4 w0a = *(const f32x4*)(cw + c8), w0b = *(const f32x4*)(cw + c8 + 4), w1a = *(const f32x4*)(cw + 1024 + c8), w1b = *(const f32x4*)(cw + 1024 + c8 + 4), w2a = *(const f32x4*)(cw + 2048 + c8), w2b = *(const f32x4*)(cw + 2048 + c8 + 4);
        float u2[8], u1[8], u0[8], gb[8]; unpack8(x2, u2); unpack8(xg, gb); unpack8(x1, u1); unpack8(x0, u0);
        if (t < 2) {
            if (samp) { const float* s1 = sc + ((size_t)bs * 2 + 1) * 1024 + c8; const float* s0 = sc + ((size_t)bs * 2 + t) * 1024 + c8;
#pragma unroll
                for (int j = 0; j < 8; ++j) { if (t == 0) u1[j] = s1[j]; u0[j] = s0[j]; } }
            else {
#pragma unroll
                for (int j = 0; j < 8; ++j) { if (t == 0) u1[j] = 0.f; u0[j] = 0.f; } }
        }
        const float w0[8] = {w0a[0], w0a[1], w0a[2], w0a[3], w0b[0], w0b[1], w0b[2], w0b[3]}, w1[8] = {w1a[0], w1a[1], w1a[2], w1a[3], w1b[0], w1b[1], w1b[2], w1b[3]}, w2[8] = {w2a[0], w2a[1], w2a[2], w2a[3], w2b[0], w2b[1], w2b[2], w2b[3]};
        float y[8];
#pragma unroll
        for (int j = 0; j < 8; ++j) y[j] = gb[j] * (w0[j] * u0[j] + w1[j] * u1[j] + w2[j] * u2[j]);
        u32x4 w; w.x = pk2(y[0], y[1]); w.y = pk2(y[2], y[3]); w.z = pk2(y[4], y[5]); w.w = pk2(y[6], y[7]);
        *(u32x4*)(A2 + (size_t)r * 2048 + 1024 + c8) = w;
        if (t >= L - 2) { float* o = P.out + (samp ? O_CS : O_CP) + ((size_t)bs * 2 + (t - (L - 2))) * 1024 + c8;
            *(f32x4*)o = (f32x4){u2[0], u2[1], u2[2], u2[3]}; *(f32x4*)(o + 4) = (f32x4){u2[4], u2[5], u2[6], u2[7]}; }
    }
}

__device__ __forceinline__ void phase3(const Params& P) {
    unsigned char* ws = P.ws;
    bf16_t* UB = (bf16_t*)(ws + OFF_UB); const float* DB = (const float*)(ws + OFF_DB);
    for (int gt = blockIdx.x * 512 + threadIdx.x; gt < 131072; gt += gridDim.x * 512) {
        const int bh = gt >> 12, rem = gt & 4095, v = rem >> 5, k4 = rem & 31;
        bf16_t* base = UB + (size_t)bh * NCH * 16384 + v * 128 + k4 * 4; const float* dp = DB + (size_t)bh * NCH * 128 + k4 * 4;
        float S[4] = {0.f, 0.f, 0.f, 0.f};
#pragma unroll 11
        for (int n = 0; n < NCH; ++n) {
            const u32x2 x = *(const u32x2*)(base + (size_t)n * 16384); const f32x4 d0 = *(const f32x4*)(dp + n * 128);
            S[0] = d0[0] * S[0] + bflo(x.x); S[1] = d0[1] * S[1] + bfhi(x.x); S[2] = d0[2] * S[2] + bflo(x.y); S[3] = d0[3] * S[3] + bfhi(x.y);
            u32x2 w; w.x = pk2(S[0], S[1]); w.y = pk2(S[2], S[3]);
            *(u32x2*)(base + (size_t)n * 16384) = w;
        }
        float* o = P.out + O_HP + ((size_t)bh * 128 + k4 * 4) * 128 + v;
#pragma unroll
        for (int i = 0; i < 4; ++i) o[(size_t)i * 128] = S[i];
    }
}
__device__ __forceinline__ void cvt_wdown(const Params& P, LAS unsigned char* lds, int gw, int NGW) {
    const int lane = threadIdx.x & 63, wave = threadIdx.x >> 6;
    LAS float* scr = (LAS float*)(lds + wave * 8704);
    for (int it = gw; it < 88 * 64; it += NGW) { const int kb = it / 64, nb = it % 64; cvt_item(P.in[17], D, (bf16_t*)(P.ws + OFF_WIN), DFF, nb * 32, kb * 64, nb * 32, scr, lane); }
}

__device__ __forceinline__ void p2c_block(const Params& P, LAS unsigned char* lds, int first, int step) {
    unsigned char* ws = P.ws;
    const float* LF = (const float*)(ws + OFF_LF); const bf16_t* KK = (const bf16_t*)(ws + OFF_KK); const bf16_t* V = (const bf16_t*)(ws + OFF_V);
    const bf16_t* QA = (const bf16_t*)(ws + OFF_QA); const bf16_t* SG = (const bf16_t*)(ws + OFF_SG); bf16_t* A2 = (bf16_t*)(ws + OFF_A2);
    const bf16_t* UB = (const bf16_t*)(ws + OFF_UB);
    LAS bf16_t* Qt = (LAS bf16_t*)lds; LAS bf16_t* Kt = (LAS bf16_t*)(lds + 17408); LAS bf16_t* Qd = (LAS bf16_t*)(lds + 34816);
    LAS bf16_t* VT = (LAS bf16_t*)(lds + 52224); LAS bf16_t* Am = (LAS bf16_t*)(lds + 70656);
    LAS float* tot = (LAS float*)(lds + 79872); LAS float* bmid = (LAS float*)(lds + 81920); LAS float* rmsp = (LAS float*)(lds + 82432);
    const int tid = threadIdx.x, k = tid & 127, tq = __builtin_amdgcn_readfirstlane(tid >> 7), lane = tid & 63, w = __builtin_amdgcn_readfirstlane(tid >> 6), fr = lane & 15, fq = lane >> 4;
    const int tt = w & 3, vh = w >> 2;
    float lfr[16]; bf16_t kr[16], qr[16]; u32x4 vx[2];
#define P2C_LOAD(item_) do { int b_, h_, n_, row0_, cv_; item_rows((item_), b_, h_, n_, row0_, cv_); \
        _Pragma("unroll") for (int i = 0; i < 16; ++i) { const int t_ = tq * 16 + i; const size_t o_ = (size_t)(row0_ + (t_ < cv_ ? t_ : cv_ - 1)) * 1024 + h_ * 128 + k; lfr[i] = LF[o_]; kr[i] = KK[o_]; qr[i] = QA[o_]; } \
        _Pragma("unroll") for (int r = 0; r < 2; ++r) { const int t_ = (tid + 512 * r) >> 4, v8_ = (tid + 512 * r) & 15; vx[r] = *(const u32x4*)(V + (size_t)(row0_ + (t_ < cv_ ? t_ : cv_ - 1)) * 1024 + h_ * 128 + v8_ * 8); } } while (0)
    if (first < NITEM_P) P2C_LOAD(first);
    for (int item = first; item < NITEM_P; item += step) {
        int b, h, n, row0, cvalid; item_rows(item, b, h, n, row0, cvalid);
        float lf[16], kv[16], qv[16]; float run = 0.f;
#pragma unroll
        for (int i = 0; i < 16; ++i) { const bool ok = tq * 16 + i < cvalid; run += ok ? lfr[i] : 0.f; lf[i] = run; kv[i] = ok ? bf2f(kr[i]) : 0.f; qv[i] = ok ? bf2f(qr[i]) : 0.f; }
        tot[tq * 128 + k] = run;
#pragma unroll
        for (int r = 0; r < 2; ++r) { const int idx = tid + 512 * r, t = idx >> 4, v8 = idx & 15; const u32x4 x = t < cvalid ? vx[r] : (u32x4){0u, 0u, 0u, 0u};
            LAS bf16_t* d = VT + (v8 * 8) * 72 + (((t >> 3) ^ (v8 & 7)) << 3) + (t & 7);
            d[0 * 72] = (bf16_t)(x.x & 0xffff); d[1 * 72] = (bf16_t)(x.x >> 16); d[2 * 72] = (bf16_t)(x.y & 0xffff); d[3 * 72] = (bf16_t)(x.y >> 16);
            d[4 * 72] = (bf16_t)(x.z & 0xffff); d[5 * 72] = (bf16_t)(x.z >> 16); d[6 * 72] = (bf16_t)(x.w & 0xffff); d[7 * 72] = (bf16_t)(x.w >> 16); }
        __syncthreads();
        float off = 0.f;
#pragma unroll
        for (int q = 0; q < 4; ++q) { const float x = tot[q * 128 + k]; if (q < tq) off += x; }
        if (tq == 2) bmid[k] = off + lf[0];
        __syncthreads();
        const float bm = bmid[k];
#pragma unroll
        for (int i = 0; i < 16; ++i) { const int t = tq * 16 + i; const float bt = off + lf[i];
            Qt[t * 136 + k] = (bf16_t)(pk2(qv[i] * fexp(bt - bm), 0.f) & 0xffff);
            Kt[t * 136 + k] = (bf16_t)(pk2(kv[i] * fexp(bm - bt), 0.f) & 0xffff);
            Qd[t * 136 + k] = (bf16_t)(pk2(qv[i] * fexp(bt), 0.f) & 0xffff); }
        bf16x8 stf[4][4]; u32x2 sgv[4]; f32x4 gnv[4];
        { const bf16_t* ST = UB + (size_t)(n > 0 ? item - 1 : item) * 16384; const int tr = tt * 16 + fr, trc = tr < cvalid ? tr : cvalid - 1;
#pragma unroll
          for (int ks = 0; ks < 4; ++ks)
#pragma unroll
              for (int i = 0; i < 4; ++i) stf[ks][i] = *(const bf16x8*)(ST + ((vh * 4 + i) * 16 + fr) * 128 + ks * 32 + fq * 8);
#pragma unroll
          for (int i = 0; i < 4; ++i) { sgv[i] = *(const u32x2*)(SG + (size_t)(row0 + trc) * 1024 + h * 128 + (vh * 4 + i) * 16 + 4 * fq); gnv[i] = *(const f32x4*)(P.in[10] + h * 128 + (vh * 4 + i) * 16 + 4 * fq); } }
        if (item + step < NITEM_P) P2C_LOAD(item + step);
        __syncthreads();
#pragma unroll
        for (int e = 0; e < 2; ++e) { const int st = 2 * vh + e; f32x4 acc = (f32x4){0.f, 0.f, 0.f, 0.f};
            if (st <= tt) {
#pragma unroll
                for (int ks = 0; ks < 4; ++ks) { const bf16x8 X = *(const LAS bf16x8*)(Kt + (st * 16 + fr) * 136 + ks * 32 + fq * 8), Y = *(const LAS bf16x8*)(Qt + (tt * 16 + fr) * 136 + ks * 32 + fq * 8);
                    acc = __builtin_amdgcn_mfma_f32_16x16x32_bf16(X, Y, acc, 0, 0, 0); }
#pragma unroll
                for (int j = 0; j < 4; ++j) if (st * 16 + 4 * fq + j > tt * 16 + fr) acc[j] = 0.f;
            }
            u32x2 o; o.x = pk2(acc[0], acc[1]); o.y = pk2(acc[2], acc[3]);
            *(LAS u32x2*)(Am + (tt * 16 + fr) * 72 + st * 16 + 4 * fq) = o; }
        __syncthreads();
        f32x4 acc[4];
#pragma unroll
        for (int i = 0; i < 4; ++i) acc[i] = (f32x4){0.f, 0.f, 0.f, 0.f};
#pragma unroll
        for (int ks = 0; ks < 2; ++ks) { const bf16x8 Y = *(const LAS bf16x8*)(Am + (tt * 16 + fr) * 72 + ks * 32 + fq * 8);
#pragma unroll
            for (int i = 0; i < 4; ++i) { const int vr = (vh * 4 + i) * 16 + fr; const bf16x8 X = *(const LAS bf16x8*)(VT + vr * 72 + (((ks * 4 + fq) ^ ((vr >> 3) & 7)) << 3)); acc[i] = __builtin_amdgcn_mfma_f32_16x16x32_bf16(X, Y, acc[i], 0, 0, 0); } }
        if (n > 0) {
#pragma unroll
            for (int ks = 0; ks < 4; ++ks) { const bf16x8 Y = *(const LAS bf16x8*)(Qd + (tt * 16 + fr) * 136 + ks * 32 + fq * 8);
#pragma unroll
                for (int i = 0; i < 4; ++i) acc[i] = __builtin_amdgcn_mfma_f32_16x16x32_bf16(stf[ks][i], Y, acc[i], 0, 0, 0); } }
        float ss = 0.f;
#pragma unroll
        for (int i = 0; i < 4; ++i) ss += (acc[i][0] * acc[i][0] + acc[i][1] * acc[i][1]) + (acc[i][2] * acc[i][2] + acc[i][3] * acc[i][3]);
        ss += __shfl_xor(ss, 16); ss += __shfl_xor(ss, 32);
        const int t = tt * 16 + fr;
        if (fq == 0) rmsp[vh * 64 + t] = ss;
        __syncthreads();
        const float scale = 1.0f / sqrtf((rmsp[t] + rmsp[64 + t]) * (1.f / 128.f) + RMS_EPS);
        if (t < cvalid) {
#pragma unroll
            for (int i = 0; i < 4; ++i) { const int v0 = (vh * 4 + i) * 16 + 4 * fq; const f32x4 gn = gnv[i];
                const u32x2 sg = sgv[i];
                u32x2 o; o.x = pk2(acc[i][0] * scale * gn[0] * bflo(sg.x), acc[i][1] * scale * gn[1] * bfhi(sg.x)); o.y = pk2(acc[i][2] * scale * gn[2] * bflo(sg.y), acc[i][3] * scale * gn[3] * bfhi(sg.y));
                *(u32x2*)(A2 + (size_t)(row0 + t) * 2048 + h * 128 + v0) = o; } }
        __syncthreads();
    }
#undef P2C_LOAD
}

__device__ __forceinline__ void skinny_glu(const Params& P, LAS unsigned char* lds, int bslot, int nbslots) {
    const bf16_t* Hs = (const bf16_t*)(P.ws + OFF_H) + (size_t)8704 * D; const bf16_t* W = (const bf16_t*)(P.ws + OFF_WGU); bf16_t* ACT = (bf16_t*)(P.ws + OFF_ACT) + (size_t)8704 * DFF;
    const int tid = threadIdx.x, lane = tid & 63, w = __builtin_amdgcn_readfirstlane(tid >> 6), fr = lane & 15, fq = lane >> 4;
    constexpr int NG = DFF / 16;
    constexpr int RS = 1040;
    const int per_round = nbslots * 8;
    LAS unsigned char* abase = lds + fr * RS + fq * 16;
    int base = 0;
    for (; base + per_round <= NG; base += per_round) {
        const int g = base + bslot * 8 + w;
        const int T = g >> 3, o = (g & 7) * 16;
        const bf16_t* wg = W + (size_t)(T * 256 + o + fr) * D + fq * 8; const bf16_t* wu = wg + (size_t)128 * D;
        f32x4 ag[4], au[4];
#pragma unroll
        for (int m = 0; m < 4; ++m) { ag[m] = (f32x4){0.f, 0.f, 0.f, 0.f}; au[m] = (f32x4){0.f, 0.f, 0.f, 0.f}; }
        bf16x8 xa[16], xb[16];
#define SK_LOAD(dst, bt) do { _Pragma("unroll") for (int i = 0; i < 8; ++i) { dst[i] = *(const bf16x8*)(wg + ((bt) * 8 + i) * 32); dst[8 + i] = *(const bf16x8*)(wu + ((bt) * 8 + i) * 32); } } while (0)
#define SK_MMA(src, half) do { _Pragma("unroll") for (int i = 0; i < 8; ++i) { _Pragma("unroll") for (int m = 0; m < 4; ++m) { \
        const bf16x8 Y = *(const LAS bf16x8*)(abase + m * 16 * RS + ((half) * 8 + i) * 64); \
        ag[m] = __builtin_amdgcn_mfma_f32_16x16x32_bf16(src[i], Y, ag[m], 0, 0, 0); au[m] = __builtin_amdgcn_mfma_f32_16x16x32_bf16(src[8 + i], Y, au[m], 0, 0, 0); } } } while (0)
        SK_LOAD(xa, 0);
#pragma unroll
        for (int ch = 0; ch < 4; ++ch) {
            __syncthreads();
            { u32x4 st[8];
#pragma unroll
              for (int r = 0; r < 8; ++r) { const int idx = tid + 512 * r, row = idx >> 6, c16 = idx & 63; st[r] = *(const u32x4*)(Hs + (size_t)row * D + ch * 512 + c16 * 8); }
#pragma unroll
              for (int r = 0; r < 8; ++r) { const int idx = tid + 512 * r, row = idx >> 6, c16 = idx & 63; *(LAS u32x4*)(lds + row * RS + c16 * 16) = st[r]; } }
            __syncthreads();
            SK_LOAD(xb, 2 * ch + 1); SK_MMA(xa, 0); if (ch < 3) SK_LOAD(xa, 2 * ch + 2); SK_MMA(xb, 1);
        }
#undef SK_LOAD
#undef SK_MMA
#pragma unroll
        for (int m = 0; m < 4; ++m) { const int row = m * 16 + fr; float a[4];
#pragma unroll
            for (int j = 0; j < 4; ++j) a[j] = silu(ag[m][j]) * au[m][j];
            u32x2 o2; o2.x = pk2(a[0], a[1]); o2.y = pk2(a[2], a[3]);
            *(u32x2*)(ACT + (size_t)row * DFF + g * 16 + 4 * fq) = o2; }
    }
    if (bslot < NG - base) {
        const int g = base + bslot;
        const int T = g >> 3, o = (g & 7) * 16;
        const bf16_t* wg = W + (size_t)(T * 256 + o + fr) * D + fq * 8 + w * 256; const bf16_t* wu = wg + (size_t)128 * D;
        const bf16_t* ha = Hs + (size_t)fr * D + fq * 8 + w * 256;
        f32x4 ag[4], au[4];
#pragma unroll
        for (int m = 0; m < 4; ++m) { ag[m] = (f32x4){0.f, 0.f, 0.f, 0.f}; au[m] = (f32x4){0.f, 0.f, 0.f, 0.f}; }
#pragma unroll
        for (int half = 0; half < 2; ++half) { bf16x8 xg[4], xu[4], ya[4][4];
#pragma unroll
            for (int i = 0; i < 4; ++i) { const int kk = (half * 4 + i) * 32; xg[i] = *(const bf16x8*)(wg + kk); xu[i] = *(const bf16x8*)(wu + kk);
#pragma unroll
                for (int m = 0; m < 4; ++m) ya[m][i] = *(const bf16x8*)(ha + (size_t)(m * 16) * D + kk); }
#pragma unroll
            for (int i = 0; i < 4; ++i)
#pragma unroll
                for (int m = 0; m < 4; ++m) { ag[m] = __builtin_amdgcn_mfma_f32_16x16x32_bf16(xg[i], ya[m][i], ag[m], 0, 0, 0); au[m] = __builtin_amdgcn_mfma_f32_16x16x32_bf16(xu[i], ya[m][i], au[m], 0, 0, 0); } }
        __syncthreads();
        LAS f32x4* red = (LAS f32x4*)lds;
#pragma unroll
        for (int m = 0; m < 4; ++m) { red[(w * 8 + m) * 64 + lane] = ag[m]; red[(w * 8 + 4 + m) * 64 + lane] = au[m]; }
        __syncthreads();
        if (w < 4) { const int m = w; f32x4 sg = (f32x4){0.f, 0.f, 0.f, 0.f}, su = (f32x4){0.f, 0.f, 0.f, 0.f};
#pragma unroll
            for (int q = 0; q < 8; ++q) { sg += red[(q * 8 + m) * 64 + lane]; su += red[(q * 8 + 4 + m) * 64 + lane]; }
            const int row = m * 16 + fr; float a[4];
#pragma unroll
            for (int j = 0; j < 4; ++j) a[j] = silu(sg[j]) * su[j];
            u32x2 o2; o2.x = pk2(a[0], a[1]); o2.y = pk2(a[2], a[3]);
            *(u32x2*)(ACT + (size_t)row * DFF + g * 16 + 4 * fq) = o2; }
    }
    __syncthreads();
}

#define XB_TMO      128
#define XB_XCNT(j)  (256  + 64 * (j))
#define XB_XSUB(j)  (1280 + 64 * (j))
#define XB_XGEN(j)  (2304 + 64 * (j))
#define XB_TOP      3328
#define XB_TOPGEN   3392
#define XCD_BAR_WORDS 3456
#define XB_SPIN_CAP (1u << 18)

__device__ __forceinline__ unsigned xb_ld(unsigned* p)              { return __hip_atomic_load(p, __ATOMIC_RELAXED, __HIP_MEMORY_SCOPE_AGENT); }
__device__ __forceinline__ unsigned xb_add(unsigned* p, unsigned v) { return __hip_atomic_fetch_add(p, v, __ATOMIC_RELAXED, __HIP_MEMORY_SCOPE_AGENT); }
__device__ __forceinline__ unsigned xb_xcc_id() { return (unsigned)__builtin_amdgcn_s_getreg((3 << 11) | 20) & 0xFu; }
#define XB_SPIN(cond, bar) do { unsigned _sp = 0; while (cond) { __builtin_amdgcn_s_sleep(1); \
    if ((++_sp & 255u) == 0u) { if (xb_ld(&(bar)[XB_TMO])) break; if (_sp > XB_SPIN_CAP) { atomicAdd(&(bar)[XB_TMO], 1u); break; } } } } while (0)

struct XcdBarrier {
    unsigned* bar; unsigned x;
    volatile LAS unsigned* st;
};

__device__ __forceinline__ XcdBarrier xcd_barrier_post(unsigned* bar, volatile LAS unsigned* st) {
    XcdBarrier b; b.bar = bar; b.x = xb_xcc_id(); b.st = st;
    if (threadIdx.x == 0) (void)xb_add(&bar[XB_XCNT(b.x)], 1u);
    return b;
}
__device__ __forceinline__ void xcd_barrier_complete(unsigned* bar, unsigned x, unsigned& nloc, unsigned& nx) {
    const unsigned G = gridDim.x * gridDim.y * gridDim.z;
    unsigned sum, cnt, mine, sp = 0u;
    for (;;) {
        sum = 0u; cnt = 0u; mine = 0u;
#pragma unroll
        for (unsigned j = 0; j < 16; ++j) { const unsigned c = xb_ld(&bar[XB_XCNT(j)]); sum += c; cnt += (c > 0u) ? 1u : 0u; mine = (j == x) ? c : mine; }
        if (sum == G) break;
        __builtin_amdgcn_s_sleep(1);
        if ((++sp & 255u) == 0u) { if (xb_ld(&bar[XB_TMO])) break; if (sp > XB_SPIN_CAP) { atomicAdd(&bar[XB_TMO], 1u); break; } }
    }
    nloc = mine > 0u ? mine : 1u; nx = cnt > 0u ? cnt : 1u;
}

__device__ __forceinline__ void xcd_barrier(const XcdBarrier& b) {
    asm volatile("s_waitcnt vmcnt(0)" ::: "memory");
    __syncthreads();
    if (threadIdx.x == 0) {
        unsigned* bar = b.bar;
        __builtin_amdgcn_s_waitcnt(0);
        unsigned nloc = b.st[0], nx = b.st[1];
        if (nloc == 0u) { xcd_barrier_complete(bar, b.x, nloc, nx); b.st[0] = nloc; b.st[1] = nx; }
        const unsigned old = xb_add(&bar[XB_XSUB(b.x)], 1u);
        const unsigned gen = old / nloc;
        if (old + 1u == (gen + 1u) * nloc) {
            __builtin_amdgcn_fence(__ATOMIC_RELEASE, "agent");
            asm volatile("s_waitcnt vmcnt(0)" ::: "memory");
            const unsigned og = xb_add(&bar[XB_TOP], 1u);
            const unsigned tg = og / nx;
            if (og + 1u == (tg + 1u) * nx) xb_add(&bar[XB_TOPGEN], 1u);
            else XB_SPIN(xb_ld(&bar[XB_TOPGEN]) == tg, bar);
            __builtin_amdgcn_fence(__ATOMIC_ACQUIRE, "agent");
            xb_add(&bar[XB_XGEN(b.x)], 1u);
            asm volatile("s_waitcnt vmcnt(0)" ::: "memory");
        } else {
            XB_SPIN(xb_ld(&bar[XB_XGEN(b.x)]) == gen, bar);
            __builtin_amdgcn_fence(__ATOMIC_ACQUIRE, "agent");
            asm volatile("s_waitcnt vmcnt(0)" ::: "memory");
        }
    }
    __syncthreads();
}

constexpr int LDS_BYTES = pg8::STAGE_BYTES + 16;
constexpr int NPHASE = 10;

__global__ void __launch_bounds__(512, 2) fwd_kernel(Params P) {
    extern __shared__ __attribute__((aligned(16))) unsigned char shm[];
    LAS unsigned char* lds = (LAS unsigned char*)shm;
    cg::grid_group grid = cg::this_grid();
    unsigned char* ws = P.ws;
    const int lo = P.ph_lo, hi = P.ph_hi, G = gridDim.x, bx = blockIdx.x;
    if (lo < 0) grid.sync();
    volatile LAS unsigned* xb_words = (volatile LAS unsigned*)(lds + pg8::STAGE_BYTES);
    if (threadIdx.x < 4) xb_words[threadIdx.x] = 0u;
    __syncthreads();
    XcdBarrier bar; bar.bar = (unsigned*)(ws + OFF_BAR); bar.x = 0; bar.st = xb_words;
    if (hi - lo > 1) bar = xcd_barrier_post((unsigned*)(ws + OFF_BAR), xb_words);
#define IN(k) (lo <= (k) && (k) < hi)
#define SEAM(k) do { if (IN(k) && IN((k) + 1)) xcd_barrier(bar); } while (0)
    if (IN(0)) phase0(P, lds);
    SEAM(0);
    if (IN(1)) {
        pg8::Gemm g{(const bf16_t*)(ws + OFF_XN), (const bf16_t*)(ws + OFF_WIN), MPAD, NIN, D}; pg8::StaticOrder S; S.init(MPAD, NIN, D, G, bx);
        EpiProj E{(bf16_t*)(ws + OFF_QA), (bf16_t*)(ws + OFF_KK), (bf16_t*)(ws + OFF_V), (bf16_t*)(ws + OFF_SG), (bf16_t*)(ws + OFF_GB), (bf16_t*)(ws + OFF_U), (float*)(ws + OFF_LF), P.in[8], P.in[9]};
        pg8::gemm_phase<EpiProj, pg8::StaticOrder>(lds, g, S, E);
    }
    SEAM(1);
    if (IN(2)) {
        for (int it = bx; it < NITEM_P + NITEM_S; it += G) { if (it < NITEM_P) p2a_item(P, lds, it); else sample_item(P, lds, it - NITEM_P); }
        conv_phase(P);
    }
    SEAM(2);
    if (IN(3)) phase3(P);
    SEAM(3);
    if (IN(4)) { p2c_block(P, lds, bx, G);
        const int nfat = NITEM_P % G;
        if (nfat > 0 && nfat < G) { if (bx >= nfat) cvt_wdown(P, lds, (bx - nfat) * 8 + (int)(threadIdx.x >> 6), (G - nfat) * 8); }
        else cvt_wdown(P, lds, bx * 8 + (int)(threadIdx.x >> 6), G * 8); }
    SEAM(4);
    if (IN(5)) {
        pg8::Gemm g{(const bf16_t*)(ws + OFF_A2), (const bf16_t*)(ws + OFF_WO), MPAD, D, D}; pg8::TailOrder S; S.init(D, G, bx, 4);
        EpiRes E{(bf16_t*)(ws + OFF_T1), (bf16_t*)(ws + OFF_SLAB2)};
        pg8::gemm_phase<EpiRes, pg8::TailOrder>(lds, g, S, E);
    }
    SEAM(5);
    if (IN(6)) { const int lane = threadIdx.x & 63, gw = bx * 8 + (threadIdx.x >> 6), NGW = G * 8;
        for (int r = gw; r < MTOK; r += NGW) {
            if (r < 8192) { f32x4 v[8]; float mean, rstd; ln_row_load_res((const bf16_t*)(ws + OFF_T1) + (size_t)r * TPB, (const bf16_t*)(ws + OFF_XN) + (size_t)r * D, lane, v, mean, rstd);
                ln_store_bf16(v, rstd, P.in[13], P.in[14], (bf16_t*)(ws + OFF_H) + (size_t)r * D, lane); }
            else { f32x4 v[8]; float mean, rstd; ln_row_load_tail<8>((const bf16_t*)(ws + OFF_SLAB2), r - 8192, (const bf16_t*)(ws + OFF_XN) + (size_t)r * D, lane, v, mean, rstd);
                ln_store_bf16(v, rstd, P.in[13], P.in[14], (bf16_t*)(ws + OFF_H) + (size_t)r * D, lane); } } }
    SEAM(6);
    if (IN(7)) {
        constexpr int MMAIN = 8704;
        pg8::Gemm g{(const bf16_t*)(ws + OFF_H), (const bf16_t*)(ws + OFF_WGU), MMAIN, NGU, D}; pg8::StaticOrder S; S.init(MMAIN, NGU, D, G, bx);
        EpiGLU E{(bf16_t*)(ws + OFF_ACT)};
        pg8::gemm_phase<EpiGLU, pg8::StaticOrder>(lds, g, S, E);
        const int nfat = ((MMAIN / 256) * (NGU / 256)) % G;
        if (nfat > 0) { if (bx >= nfat) skinny_glu(P, lds, bx - nfat, G - nfat); } else skinny_glu(P, lds, bx, G);
    }
    SEAM(7);
    if (IN(8)) {
        pg8::Gemm g{(const bf16_t*)(ws + OFF_ACT), (const bf16_t*)(ws + OFF_WIN), MPAD, D, DFF}; pg8::TailOrder S; S.init(DFF, G, bx, 10);
        EpiRes E{(bf16_t*)(ws + OFF_T2), (bf16_t*)(ws + OFF_SLAB4)};
        pg8::gemm_phase<EpiRes, pg8::TailOrder>(lds, g, S, E);
    }
    SEAM(8);
    if (IN(9)) { const int lane = threadIdx.x & 63, gw = bx * 8 + (threadIdx.x >> 6), NGW = G * 8;
        for (int r = gw; r < MTOK; r += NGW) { float* o;
            if (r < MPR) { const int b = r / LP, t = r % LP; if (t < 16) continue; o = P.out + O_YP + ((size_t)b * 2048 + (t - 16)) * D; } else o = P.out + O_YS + (size_t)(r - MPR) * D;
            if (r < 8192) { f32x4 v[8]; float mean, rstd; ln_row_load_res((const bf16_t*)(ws + OFF_T2) + (size_t)r * TPB, (const bf16_t*)(ws + OFF_H) + (size_t)r * D, lane, v, mean, rstd);
                ln_store_f32(v, rstd, P.in[18], P.in[19], o, lane); }
            else { f32x4 v[8]; float mean, rstd; ln_row_load_tail<9>((const bf16_t*)(ws + OFF_SLAB4), r - 8192, (const bf16_t*)(ws + OFF_H) + (size_t)r * D, lane, v, mean, rstd);
                ln_store_f32(v, rstd, P.in[18], P.in[19], o, lane); } } }
#undef IN
#undef SEAM
}

extern "C" void kernel_launch(void* const* d_in, const int* in_sizes, int n_in, void* d_out, int out_size, void* d_ws, size_t ws_size, hipStream_t stream) {
    static int grid = 0;
    if (grid == 0) {
        if (n_in != 20 || ws_size < WS_END) { fprintf(stderr, "kernel_launch: need 20 inputs and %zu bytes of workspace; got %d, %zu\n", (size_t)WS_END, n_in, ws_size); grid = -1; return; }
        int dev = 0, cus = 0, per_cu = 0;
        (void)hipGetDevice(&dev); (void)hipDeviceGetAttribute(&cus, hipDeviceAttributeMultiprocessorCount, dev);
        if (hipFuncSetAttribute((const void*)fwd_kernel, hipFuncAttributeMaxDynamicSharedMemorySize, LDS_BYTES) != hipSuccess) { fprintf(stderr, "kernel_launch: hipFuncSetAttribute failed\n"); grid = -1; return; }
        (void)hipOccupancyMaxActiveBlocksPerMultiprocessor(&per_cu, (const void*)fwd_kernel, 512, LDS_BYTES);
        if (per_cu < 1) per_cu = 1;
        (void)hipGetLastError();
        grid = cus * 1;
    }
    if (grid < 0) return;
    Params p{};
    for (int i = 0; i < 20; ++i) p.in[i] = (const float*)d_in[i];
    p.out = (float*)d_out; p.ws = (unsigned char*)d_ws;
#if N_LAUNCH_MODE == 1
    for (int ph = 0; ph < NPHASE; ++ph) { p.ph_lo = ph; p.ph_hi = ph + 1; hipLaunchKernelGGL(fwd_kernel, dim3(grid), dim3(512), LDS_BYTES, stream, p); }
#else
    p.ph_lo = 0; p.ph_hi = NPHASE;
    (void)hipMemsetAsync((unsigned char*)d_ws + OFF_BAR, 0, 16384, stream);
    void* args[] = {&p};
    hipError_t e = hipLaunchCooperativeKernel((const void*)fwd_kernel, dim3(grid), dim3(512), args, LDS_BYTES, stream);
    if (e != hipSuccess) fprintf(stderr, "cooperative launch failed: %s (grid %d)\n", hipGetErrorString(e), grid);
#endif
}
```
